# Optimizing an MI355X kernel written in HIP

```python
import jax, jax.numpy as jnp
from jax import lax
import numpy as np


D_MODEL = 2048
BATCH = 4
SEQ = 4096
DEPTH = 1

N_META = 16
BLOCK = 128
NORM_EPS = 1e-6

RWKV_HEADS = 16
RWKV_HEAD = 64
RWKV_DIM = RWKV_HEADS * RWKV_HEAD
DECAY_LORA = 64
ICLR_LORA = 64
GATE_LORA = 160
GN_EPS = 64e-5

MLA_HEADS = 16
Q_LORA = 512
KV_LORA = 512
QK_NOPE = 128
QK_ROPE = 64
V_HEAD = 128
MLA_DIM = MLA_HEADS * V_HEAD
ROPE_THETA = 10000.0

N_KEYS = 128
N_EXPERTS = N_KEYS * N_KEYS
PEER_HEADS = 8
PEER_QDIM = 256
PEER_HALF = PEER_QDIM // 2
PEER_TOPK = 16

RWKV_SPLIT = (RWKV_DIM, RWKV_DIM, RWKV_DIM, GATE_LORA, DECAY_LORA, DECAY_LORA, ICLR_LORA, ICLR_LORA)
RWKV_COLS = sum(RWKV_SPLIT)
IN_SPLIT = (RWKV_COLS, Q_LORA, KV_LORA, QK_ROPE, D_MODEL, D_MODEL)
IN_COLS = sum(IN_SPLIT)

kernel_name = 'hybrid_rwkv7_mla_peer_encoder_block'


def split_cols(t, sizes):
    return jnp.split(t, np.cumsum(sizes)[:-1].tolist(), axis=-1)


def rmsnorm(x, g):
    xf = x.astype(jnp.float32)
    y = xf * lax.rsqrt(jnp.mean(xf * xf, axis=-1, keepdims=True) + NORM_EPS)
    return (y * g.astype(jnp.float32)).astype(x.dtype)


def centred_shift(p, c):
    prev = jnp.pad(p, ((0, 0), (1, 0), (0, 0)))[:, :-1]
    nxt = jnp.pad(p, ((0, 0), (0, 1), (0, 0)))[:, 1:]
    return c[0] * prev + c[1] * p + c[2] * nxt


def wkv7_scan(r, w, k, v, a, b):
    Bsz, L, H, N = r.shape

    def step(S, inp):
        r_t, w_t, k_t, v_t, a_t, b_t = inp
        sa = jnp.einsum('bhij,bhj->bhi', S, a_t)
        S = S * w_t[:, :, None, :] + sa[..., None] * b_t[:, :, None, :] + v_t[..., None] * k_t[:, :, None, :]
        return S, jnp.einsum('bhij,bhj->bhi', S, r_t)

    xs = tuple(jnp.moveaxis(t, 1, 0) for t in (r, w, k, v, a, b))
    S0 = jnp.zeros((Bsz, H, N, N), jnp.float32)
    _, y = lax.scan(step, S0, xs)
    return jnp.moveaxis(y, 0, 1)


def rwkv7_branch(cols, shift_c, w_up, w0, a_up, a0, g_up, k_k, k_a, r_k, ln_g, ln_b):
    f32 = jnp.float32
    Bsz, L, _ = cols.shape
    xs = centred_shift(cols.astype(f32), shift_c.astype(f32))
    r, k, v, g_d, wd_f, wd_b, ad_f, ad_b = split_cols(xs, RWKV_SPLIT)
    heads = lambda t: t.reshape(t.shape[:-1] + (RWKV_HEADS, RWKV_HEAD))
    g = jax.nn.sigmoid(g_d) @ g_up.astype(f32)
    kk = heads(k * k_k.astype(f32))
    kk = kk / jnp.maximum(jnp.linalg.norm(kk, axis=-1, keepdims=True), 1e-12)
    rh, kh, vh = heads(r), heads(k), heads(v)

    def direction(wd, ad, d, reverse):
        w_log = -jax.nn.softplus(-(w0[d].astype(f32) + jnp.tanh(wd) @ w_up[d].astype(f32))) - 0.5
        decay = jnp.exp(-jnp.exp(heads(w_log)))
        iclr = jax.nn.sigmoid(heads(a0[d].astype(f32) + ad @ a_up[d].astype(f32)))
        kt = kh * (1.0 + (iclr - 1.0) * heads(k_a.astype(f32)))
        ins = (rh, decay, kt, vh, -kk, kk * iclr)
        if reverse:
            ins = tuple(jnp.flip(t, 1) for t in ins)
        y = wkv7_scan(*ins)
        if reverse:
            y = jnp.flip(y, 1)
        return y, kt

    y_f, kt_f = direction(wd_f, ad_f, 0, False)
    y_b, kt_b = direction(wd_b, ad_b, 1, True)
    y = y_f + y_b
    mu = jnp.mean(y, axis=-1, keepdims=True)
    var = jnp.mean(jnp.square(y - mu), axis=-1, keepdims=True)
    y = ((y - mu) * lax.rsqrt(var + GN_EPS)).reshape(Bsz, L, RWKV_DIM) * ln_g.astype(f32) + ln_b.astype(f32)
    bonus = jnp.sum(rh * (0.5 * (kt_f + kt_b)) * r_k.astype(f32), axis=-1, keepdims=True) * vh
    return ((y + bonus.reshape(Bsz, L, RWKV_DIM)) * g).astype(cols.dtype)


def apply_rope(x, cos, sin):
    x1, x2 = jnp.split(x, 2, axis=-1)
    return jnp.concatenate([x1 * cos - x2 * sin, x1 * sin + x2 * cos], axis=-1)


def mla_branch(q_d, kv_d, k_rope_raw, q_norm_g, w_uq, kv_norm_g, w_ukv, cos, sin):
    Bsz, L, _ = q_d.shape
    q = (rmsnorm(q_d, q_norm_g) @ w_uq).reshape(Bsz, L, MLA_HEADS, QK_NOPE + QK_ROPE)
    q_nope = q[..., :QK_NOPE]
    q_rope = apply_rope(q[..., QK_NOPE:], cos[:, None, :], sin[:, None, :])
    kv = (rmsnorm(kv_d, kv_norm_g) @ w_ukv).reshape(Bsz, L, MLA_HEADS, QK_NOPE + V_HEAD)
    k_nope, v = kv[..., :QK_NOPE], kv[..., QK_NOPE:]
    k_rope = apply_rope(k_rope_raw, cos, sin)
    pad = (-N_META) % BLOCK
    Lq = L + pad
    nblk = Lq // BLOCK
    to_blocks = lambda t: jnp.pad(t, ((0, 0), (pad, 0), (0, 0), (0, 0))).reshape(
        Bsz, nblk, BLOCK, MLA_HEADS, t.shape[-1]).transpose(1, 0, 2, 3, 4)
    qn_blk, qr_blk = to_blocks(q_nope), to_blocks(q_rope)
    scale = (QK_NOPE + QK_ROPE) ** -0.5

    def attend(blk):
        qn_b, qr_b = blk
        s = jnp.einsum('bqhd,bkhd->bhqk', qn_b, k_nope) + jnp.einsum('bqhd,bkd->bhqk', qr_b, k_rope)
        p = jax.nn.softmax(s.astype(jnp.float32) * scale, axis=-1).astype(v.dtype)
        return jnp.einsum('bhqk,bkhd->bqhd', p, v)

    o = lax.map(attend, (qn_blk, qr_blk))
    return o.transpose(1, 0, 2, 3, 4).reshape(Bsz, Lq, MLA_DIM)[:, pad:]


def peer_ffn(h, w_q, sub_keys, u_tab, v_tab):
    Bsz, L, D = h.shape
    q = (h @ w_q).reshape(Bsz, L, PEER_HEADS, 2, PEER_HALF)
    s = jnp.einsum('blhpd,hpnd->blhpn', q, sub_keys)
    top_s, top_i = lax.top_k(s, PEER_TOPK)
    cand = top_s[..., 0, :, None] + top_s[..., 1, None, :]
    best_s, best_c = lax.top_k(cand.reshape(Bsz, L, PEER_HEADS, PEER_TOPK * PEER_TOPK), PEER_TOPK)
    i1 = jnp.take_along_axis(top_i[..., 0, :], best_c // PEER_TOPK, axis=-1)
    i2 = jnp.take_along_axis(top_i[..., 1, :], best_c % PEER_TOPK, axis=-1)
    expert = i1 * N_KEYS + i2
    gate = jax.nn.softmax(best_s.astype(jnp.float32), axis=-1).astype(h.dtype)
    pad = (-N_META) % BLOCK
    Lp = L + pad
    nblk = Bsz * Lp // BLOCK
    padt = lambda t: jnp.pad(t, ((0, 0), (pad, 0)) + ((0, 0),) * (t.ndim - 2))
    h_blk = padt(h).reshape(nblk, BLOCK, D)
    e_blk = padt(expert).reshape(nblk, BLOCK, PEER_HEADS, PEER_TOPK)
    g_blk = padt(gate).reshape(nblk, BLOCK, PEER_HEADS, PEER_TOPK)

    def experts(blk):
        h_b, e_b, g_b = blk
        u = jnp.take(u_tab, e_b, axis=0)
        act = jax.nn.gelu(jnp.einsum('td,thkd->thk', h_b, u), approximate=False) * g_b
        return jnp.einsum('thk,thkd->td', act, jnp.take(v_tab, e_b, axis=0))

    out = lax.map(experts, (h_blk, e_blk, g_blk))
    return out.reshape(Bsz, Lp, D)[:, pad:]


def setup_inputs(seed: int = 0) -> dict:
    key = jax.random.key(seed)
    ks = jax.random.split(key, 32)
    nrm = lambda k, shape, scale: jax.random.normal(k, shape, jnp.float32) * scale
    n_idx = jnp.arange(RWKV_DIM, dtype=jnp.float32) / (RWKV_DIM - 1)
    decay_base = -6.5 + 5.0 * n_idx ** 0.85
    shift_base = jnp.array([0.25, 0.5, 0.25], jnp.float32)[:, None]
    return {
        'x': nrm(ks[0], (BATCH, SEQ, D_MODEL), 1.0),
        'meta_tokens': nrm(ks[1], (N_META, D_MODEL), 1.0),
        'norm_mix_g': 1.0 + nrm(ks[2], (DEPTH, D_MODEL), 0.02),
        'w_in': nrm(ks[3], (DEPTH, D_MODEL, IN_COLS), D_MODEL ** -0.5),
        'b_gate': nrm(ks[4], (DEPTH, 2 * D_MODEL), 0.02),
        'shift_c': shift_base + nrm(ks[5], (DEPTH, 3, RWKV_COLS), 0.05),
        'w_up': nrm(ks[6], (DEPTH, 2, DECAY_LORA, RWKV_DIM), 0.1 * DECAY_LORA ** -0.5),
        'w0': decay_base + nrm(ks[7], (DEPTH, 2, RWKV_DIM), 0.1),
        'a_up': nrm(ks[8], (DEPTH, 2, ICLR_LORA, RWKV_DIM), 0.5 * ICLR_LORA ** -0.5),
        'a0': nrm(ks[9], (DEPTH, 2, RWKV_DIM), 0.1),
        'g_up': nrm(ks[10], (DEPTH, GATE_LORA, RWKV_DIM), GATE_LORA ** -0.5),
        'k_k': 0.85 + nrm(ks[11], (DEPTH, RWKV_DIM), 0.02),
        'k_a': 1.0 + nrm(ks[12], (DEPTH, RWKV_DIM), 0.02),
        'r_k': nrm(ks[13], (DEPTH, RWKV_HEADS, RWKV_HEAD), 0.1),
        'ln_x_g': 1.0 + nrm(ks[14], (DEPTH, RWKV_DIM), 0.02),
        'ln_x_b': nrm(ks[15], (DEPTH, RWKV_DIM), 0.02),
        'q_norm_g': 1.0 + nrm(ks[16], (DEPTH, Q_LORA), 0.02),
        'w_uq': nrm(ks[17], (DEPTH, Q_LORA, MLA_HEADS * (QK_NOPE + QK_ROPE)), Q_LORA ** -0.5),
        'kv_norm_g': 1.0 + nrm(ks[18], (DEPTH, KV_LORA), 0.02),
        'w_ukv': nrm(ks[19], (DEPTH, KV_LORA, MLA_HEADS * (QK_NOPE + V_HEAD)), KV_LORA ** -0.5),
        'p_rwkv': nrm(ks[20], (DEPTH, RWKV_DIM, D_MODEL), RWKV_DIM ** -0.5),
        'p_mla': nrm(ks[21], (DEPTH, MLA_DIM, D_MODEL), MLA_DIM ** -0.5),
        'w_o': nrm(ks[22], (DEPTH, D_MODEL, D_MODEL), D_MODEL ** -0.5),
        'norm_ffn_g': 1.0 + nrm(ks[23], (DEPTH, D_MODEL), 0.02),
        'peer_wq': nrm(ks[24], (DEPTH, D_MODEL, PEER_HEADS * PEER_QDIM), D_MODEL ** -0.5),
        'peer_keys': nrm(ks[25], (DEPTH, PEER_HEADS, 2, N_KEYS, PEER_HALF), PEER_HALF ** -0.5),
        'peer_u': nrm(ks[26], (DEPTH, N_EXPERTS, D_MODEL), D_MODEL ** -0.5),
        'peer_v': nrm(ks[27], (DEPTH, N_EXPERTS, D_MODEL), PEER_HEADS ** -0.5),
        'final_norm_g': 1.0 + nrm(ks[28], (D_MODEL,), 0.02),
    }


def reference(x, meta_tokens, norm_mix_g, w_in, b_gate, shift_c, w_up, w0, a_up, a0, g_up, k_k, k_a, r_k,
              ln_x_g, ln_x_b, q_norm_g, w_uq, kv_norm_g, w_ukv, p_rwkv, p_mla, w_o, norm_ffn_g,
              peer_wq, peer_keys, peer_u, peer_v, final_norm_g):
    Bsz = x.shape[0]
    meta = jnp.broadcast_to(meta_tokens.astype(x.dtype)[None], (Bsz, N_META, D_MODEL))
    h = jnp.concatenate([meta, x], axis=1)
    L = h.shape[1]
    pos = jnp.arange(L, dtype=jnp.float32)
    inv_freq = ROPE_THETA ** (-jnp.arange(0, QK_ROPE, 2, dtype=jnp.float32) / QK_ROPE)
    ang = pos[:, None] * inv_freq[None, :]
    cos, sin = jnp.cos(ang).astype(x.dtype), jnp.sin(ang).astype(x.dtype)
    for l in range(DEPTH):
        n = rmsnorm(h, norm_mix_g[l])
        proj = n @ w_in[l]
        rw_cols, q_d, kv_d, k_rope_raw, gr_pre, gm_pre = split_cols(proj, IN_SPLIT)
        y_r = rwkv7_branch(rw_cols, shift_c[l], w_up[l], w0[l], a_up[l], a0[l], g_up[l],
                           k_k[l], k_a[l], r_k[l], ln_x_g[l], ln_x_b[l])
        y_m = mla_branch(q_d, kv_d, k_rope_raw, q_norm_g[l], w_uq[l], kv_norm_g[l], w_ukv[l], cos, sin)
        gates = jax.nn.sigmoid(jnp.concatenate([gr_pre, gm_pre], axis=-1) + b_gate[l])
        g_r, g_m = jnp.split(gates, 2, axis=-1)
        merged = g_r * (y_r @ p_rwkv[l]) + g_m * (y_m @ p_mla[l])
        h = h + merged @ w_o[l]
        h = h + peer_ffn(rmsnorm(h, norm_ffn_g[l]), peer_wq[l], peer_keys[l], peer_u[l], peer_v[l])
    return rmsnorm(h, final_norm_g)[:, N_META:]
```

```cpp
#include <hip/hip_runtime.h>
#include <hip/hip_cooperative_groups.h>
#include <cstdio>
#include <cstdint>
namespace cg = cooperative_groups;

constexpr int NWAVES = 8;
constexpr int BATCH = 4, SEQ = 4096, DM = 2048, NMETA = 16, LTOK = SEQ + NMETA;
constexpr int TOK = BATCH * LTOK;
constexpr int TP = 16640;
constexpr int RW_DIM = 1024, RW_H = 16, RW_N = 64;
constexpr int NPROJ = 4608;
constexpr int C_QD = 3584, C_KVD = 4096, C_KR = 3488, NPROJ_A = 1024, NPROJ_B = NPROJ - NPROJ_A;
constexpr int MLA_H = 16, QK_NOPE = 128, QK_ROPE = 64, QK_D = 192, V_D = 128;
constexpr int NQ = MLA_H * QK_D;
constexpr int NKV = MLA_H * (QK_NOPE + V_D);
constexpr float NORM_EPS = 1e-6f;
constexpr float QSCALE = 0.07216878364870322f * 1.4426950408889634f;

constexpr size_t MiB = 1u << 20;
constexpr size_t WS_WSCORE = 0;
constexpr size_t WS_WIN    = 8 * MiB;
constexpr size_t WS_WIN8   = 12 * MiB;
constexpr size_t WS_XN8T   = 166 * MiB;
constexpr size_t WS_WG     = 27 * MiB;
constexpr size_t WS_WUQ    = 43 * MiB;
constexpr size_t WS_WUKV   = 46 * MiB;
constexpr size_t WS_WPR    = 50 * MiB;
constexpr size_t WS_WPM    = 54 * MiB;
constexpr size_t WS_WO     = 62 * MiB;
constexpr size_t WS_WLG    = 70 * MiB;
constexpr size_t WS_WLW    = 71 * MiB;
constexpr size_t WS_AFULL  = 75 * MiB;
constexpr size_t WS_WQBF   = 83 * MiB;
constexpr size_t WS_XN     = 96 * MiB;
constexpr size_t SZ_T512   = (size_t)TP * 512 * 2;
constexpr int NREAL = BATCH * SEQ;
constexpr size_t WS_YR8    = 96 * MiB;
constexpr size_t WS_AW     = 96 * MiB;
constexpr size_t WS_AG     = 105 * MiB;
constexpr size_t WS_QN     = 113 * MiB;
constexpr size_t WS_KVN    = 130 * MiB;
constexpr size_t WS_KR     = 147 * MiB;
constexpr size_t SZ_T1024  = (size_t)TP * 1024 * 2;
constexpr size_t WS_RKV    = 166 * MiB;
constexpr size_t WS_PROJ   = 263 * MiB + 512 * 1024;
constexpr size_t WS_OMIC   = 263 * MiB + 512 * 1024;
constexpr size_t WS_G      = 393 * MiB + 512 * 1024;
constexpr size_t WS_Y      = 426 * MiB;
constexpr size_t WS_Q      = 166 * MiB;
constexpr size_t WS_KV     = 263 * MiB + 512 * 1024;
constexpr size_t WS_V      = 298 * MiB;
constexpr size_t WS_O      = 426 * MiB;
constexpr size_t WS_M8     = 458 * MiB;
constexpr size_t WS_BUF1   = 166 * MiB;
constexpr size_t WS_BUF2   = 231 * MiB;
constexpr size_t WS_H1     = 296 * MiB;
constexpr size_t WS_N2     = 166 * MiB;
constexpr size_t WS_SSQ    = 154 * MiB;
constexpr size_t WS_RSTD   = 156 * MiB;
constexpr int TROW = 1152;
constexpr size_t WS_UQ     = 8 * MiB;
constexpr size_t WS_VQ     = 75 * MiB;
constexpr size_t WS_SC     = 360 * MiB;
constexpr size_t WS_ROPE   = 492 * MiB;
constexpr size_t WS_CTL    = 495 * MiB;
constexpr size_t XB_OFF    = 32 * MiB;
constexpr size_t WS_END    = 496 * MiB;
static_assert(WS_KR + (size_t)TP * 64 * 2 <= 166 * MiB, "XNR region");
static_assert(WS_PROJ + (size_t)TP * NPROJ * 2 <= 418 * MiB + 512 * 1024, "proj");

#define GAS __attribute__((address_space(1)))
#define LAS __attribute__((address_space(3)))
typedef unsigned short bf16;
typedef unsigned v4u __attribute__((ext_vector_type(4)));
typedef unsigned v2u __attribute__((ext_vector_type(2)));
typedef float f32x4v __attribute__((ext_vector_type(4)));
#define LDS_WAIT() asm volatile("s_waitcnt lgkmcnt(0)" ::: "memory")
#define VM_WAIT() asm volatile("s_waitcnt vmcnt(0)" ::: "memory")
__device__ __forceinline__ unsigned pk2(float lo, float hi) { unsigned r; asm volatile("v_cvt_pk_bf16_f32 %0, %1, %2" : "=v"(r) : "v"(lo), "v"(hi)); return r; }
__device__ __forceinline__ float bf_lo(unsigned w) { return __uint_as_float(w << 16); }
__device__ __forceinline__ float bf_hi(unsigned w) { return __uint_as_float(w & 0xffff0000u); }
__device__ __forceinline__ float bf2f(bf16 h) { return __uint_as_float((unsigned)h << 16); }
__device__ __forceinline__ float wave_sum(float v) {
#pragma unroll
    for (int o = 1; o < 64; o <<= 1) v += __shfl_xor(v, o);
    return v;
}
__device__ __forceinline__ float f8c(float x) { return __builtin_amdgcn_fmed3f(x, -448.f, 448.f); }
__device__ __forceinline__ unsigned pk4_f8(float a, float b, float c, float d) { const int w = __builtin_amdgcn_cvt_pk_fp8_f32(f8c(a), f8c(b), 0, false); return (unsigned)__builtin_amdgcn_cvt_pk_fp8_f32(f8c(c), f8c(d), w, true); }
constexpr float F8S_W = 256.f, F8S_XN = 8.f, F8S_O = 128.f, F8S_M = 16.f, F8S_Y = 8.f, F8S_Q = 64.f, F8S_K = 8.f, F8S_V = 8.f;
constexpr int NTV = 66;
__device__ __forceinline__ float sigmoidf_(float x) { return 1.0f / (1.0f + __expf(-x)); }

struct Args { const float* in[29]; float* out; unsigned char* ws; };
enum { I_X = 0, I_META, I_NMG, I_WIN, I_BGATE, I_SHIFT, I_WUP, I_W0, I_AUP, I_A0, I_GUP, I_KK, I_KA, I_RK, I_LNG, I_LNB, I_QNG, I_WUQ, I_KVNG, I_WUKV,
       I_PRW, I_PMLA, I_WO, I_NFG, I_PWQ, I_PKEYS, I_PU, I_PV, I_FNG };
namespace pg8 {
#define PG8_LAS __attribute__((address_space(3)))
typedef unsigned short bf16_t;
typedef short bf16x8 __attribute__((ext_vector_type(8)));
typedef float f32x4 __attribute__((ext_vector_type(4)));
typedef unsigned u32x4 __attribute__((ext_vector_type(4)));
constexpr int BM = 256, BK = 64, HALF = 128, HTB = HALF * BK * 2  , STAGE_BYTES = 8 * HTB, NXCD = 8, WGM = 8;

__host__ __device__ __forceinline__ int lds_byte(int r, int c) { const int st = (r >> 4) * 2 + (c >> 5), rr = r & 15, cc = c & 31, ob = rr * 64 + cc * 2; return st * 1024 + (ob ^ (((ob >> 9) & 1) << 5)); }
__host__ __device__ __forceinline__ void stage_rc(int b, int& R, int& C) { const int st = b / 1024, sb = b % 1024, swz = sb ^ (((sb >> 9) & 1) << 5); R = (st >> 1) * 16 + swz / 64; C = (st & 1) * 32 + (swz % 64) / 2; }
__host__ __device__ __forceinline__ int perm32(int rho) { const int n = rho >> 4, i = rho & 15; return 8 * (i >> 2) + 4 * n + (i & 3); }

struct Unit { int pm, pn; };
struct Gemm { const bf16_t* A; const bf16_t* Bt; int M, N, K; int ld = 0, kwin = 0; };

struct StaticOrder {
    int nM, nN, nwg, G, c;
    __host__ __device__ void init(int M, int N, int G_, int c_) { nM = M / BM; nN = N / BM; nwg = nM * nN; G = G_; c = c_; }
    __host__ __device__ bool next(int i, Unit& u) const {
        const long L = (long)i * G + c; if (c < 0 || L >= nwg) return false;
        int wgid = (int)L; { const int q = nwg / NXCD, r = nwg % NXCD, xcd = wgid % NXCD, off = wgid / NXCD; wgid = (xcd < r ? xcd * (q + 1) : r * (q + 1) + (xcd - r) * q) + off; }
        const int nig = WGM * nN, gid = wgid / nig, fm = gid * WGM, gsz = (nM - fm) < WGM ? (nM - fm) : WGM;
        u.pm = fm + ((wgid % nig) % gsz); u.pn = (wgid % nig) / gsz; return true;
    }
    __device__ __forceinline__ void a_ready(const Unit&) const {}
    __device__ __forceinline__ void done(const Unit&) const {}
};

__device__ __forceinline__ unsigned cvt_pk_bf16(float lo, float hi) { unsigned r; asm volatile("v_cvt_pk_bf16_f32 %0, %1, %2" : "=v"(r) : "v"(lo), "v"(hi)); return r; }
typedef float f32x2 __attribute__((ext_vector_type(2)));
typedef int i32x8 __attribute__((ext_vector_type(8)));
typedef int i32x4 __attribute__((ext_vector_type(4)));
__device__ __forceinline__ void mfma_f8(f32x4& acc, const i32x8 a, const i32x8 b) { asm volatile("v_mfma_f32_16x16x128_f8f6f4 %0, %1, %2, %0" : "+v"(acc) : "v"(a), "v"(b)); }
__device__ __forceinline__ i32x8 cat8(bf16x8 lo, bf16x8 hi) { const i32x4 a = __builtin_bit_cast(i32x4, lo), b = __builtin_bit_cast(i32x4, hi); return (i32x8){a[0], a[1], a[2], a[3], b[0], b[1], b[2], b[3]}; }

template <class Epi, class Sched, bool ALIGN_EPI = false, bool SP2 = false, bool FP8 = false>
__device__ __forceinline__ void gemm_phase(PG8_LAS unsigned char* lds, const Gemm g, const Sched& S, const Epi& E) {
    int tid_ = threadIdx.x; asm volatile("" : "+v"(tid_));
    const int tid = tid_, wid = __builtin_amdgcn_readfirstlane(tid >> 6), lane = tid & 63, wr = wid >> 2, wc = wid & 3, fr = lane & 15, fq = lane >> 4;
    int nt_ = g.K / BK; if constexpr (FP8) asm volatile("" : "+s"(nt_));
    const int K = g.K, nt = nt_, ld = g.ld ? g.ld : g.K; const size_t kwb = (size_t)g.kwin * 2;
    unsigned voffA[2], voffB[2];
#pragma unroll
    for (int i = 0; i < 2; ++i) { int R, C; stage_rc(tid * 16 + i * 8192, R, C); const int Rb = Epi::PERM ? ((R & ~31) + perm32(R & 31)) : R;
        voffA[i] = (unsigned)(R * ld + C) * 2u; voffB[i] = (unsigned)(Rb * ld + C) * 2u; }
    const size_t kstep = (size_t)(BK * 2);
    const size_t hstep = (size_t)HALF * ld * 2;
    const size_t tstep = 2 * hstep;
    const unsigned ldsw = (unsigned)wid * 1024u;
    const int aoff = lds_byte(wr * 64 + fr, fq * 8), boff = lds_byte(wc * 32 + fr, fq * 8);
#define PG8_SA(b, h) (((b) * 2 + (h)) * HTB)
#define PG8_SB(b, h) ((4 + (b) * 2 + (h)) * HTB)
#define PG8_STAGE(bufoff, gbase, voff) do { _Pragma("unroll") for (int _i = 0; _i < 2; ++_i) \
        __builtin_amdgcn_global_load_lds((const unsigned*)((const char*)(gbase) + (voff)[_i]), (PG8_LAS unsigned*)(lds + (bufoff) + ldsw + _i * 8192), 16, 0, 0); } while (0)
#define PG8_LDA(dst, b, h) do { _Pragma("unroll") for (int m = 0; m < 4; ++m) _Pragma("unroll") for (int k = 0; k < 2; ++k) dst[m][k] = *(const PG8_LAS bf16x8*)(lds + PG8_SA(b, h) + aoff + m * 2048 + k * 1024); } while (0)
#define PG8_LDB(dst, b, h) do { _Pragma("unroll") for (int n = 0; n < 2; ++n) _Pragma("unroll") for (int k = 0; k < 2; ++k) dst[n][k] = *(const PG8_LAS bf16x8*)(lds + PG8_SB(b, h) + boff + n * 2048 + k * 1024); } while (0)
#define PG8_MMA(ai, bj, At, Bt) do { __builtin_amdgcn_s_setprio(1); _Pragma("unroll") for (int m = 0; m < 4; ++m) _Pragma("unroll") for (int n = 0; n < 2; ++n) { \
        if constexpr (FP8) mfma_f8(acc[ai][bj][m][n], cat8(Bt[n][0], Bt[n][1]), cat8(At[m][0], At[m][1])); \
        else { _Pragma("unroll") for (int k = 0; k < 2; ++k) acc[ai][bj][m][n] = __builtin_amdgcn_mfma_f32_16x16x32_bf16(Bt[n][k], At[m][k], acc[ai][bj][m][n], 0, 0, 0); } } \
        __builtin_amdgcn_s_setprio(0); } while (0)
#define PG8_WAIT_V(n) asm volatile("s_waitcnt vmcnt(" #n ")" ::: "memory")
#define PG8_WAIT_L(n) asm volatile("s_waitcnt lgkmcnt(" #n ")" ::: "memory")
#define PG8_BAR __builtin_amdgcn_s_barrier()
#define PG8_SCHED __builtin_amdgcn_sched_barrier(0)
    Unit cur, nxt; int ui = 0;
    if (!S.next(0, cur)) return;
    f32x4 acc[2][2][4][2];
#pragma unroll
    for (int a = 0; a < 2; ++a)
#pragma unroll
        for (int b = 0; b < 2; ++b)
#pragma unroll
            for (int m = 0; m < 4; ++m)
#pragma unroll
                for (int n = 0; n < 2; ++n) acc[a][b][m][n] = (f32x4){0.f, 0.f, 0.f, 0.f};
    bf16x8 At[4][2], B0[2][2], B1[2][2];
    const char* cA = (const char*)g.A + (size_t)cur.pm * tstep + (size_t)cur.pm * kwb; const char* cB = (const char*)g.Bt + (size_t)cur.pn * tstep + (size_t)cur.pm * kwb;
    S.a_ready(cur);
    if constexpr (SP2) {
        PG8_STAGE(PG8_SB(0, 0), cB, voffB); PG8_STAGE(PG8_SB(0, 1), cB + hstep, voffB); PG8_STAGE(PG8_SA(0, 0), cA, voffA); PG8_STAGE(PG8_SA(0, 1), cA + hstep, voffA);
        if (wr == 1) PG8_BAR;
        PG8_WAIT_V(2); PG8_BAR;
        PG8_STAGE(PG8_SB(1, 0), cB + kstep, voffB); PG8_STAGE(PG8_SA(1, 0), cA + kstep, voffA); PG8_STAGE(PG8_SB(1, 1), cB + hstep + kstep, voffB);
        PG8_WAIT_V(6); PG8_BAR;
    } else {
        PG8_STAGE(PG8_SB(0, 0), cB, voffB); PG8_STAGE(PG8_SA(0, 0), cA, voffA); PG8_STAGE(PG8_SB(0, 1), cB + hstep, voffB); PG8_STAGE(PG8_SA(0, 1), cA + hstep, voffA);
        if (wr == 1) PG8_BAR;
        PG8_WAIT_V(4); PG8_BAR;
        PG8_STAGE(PG8_SB(1, 0), cB + kstep, voffB); PG8_STAGE(PG8_SA(1, 0), cA + kstep, voffA); PG8_STAGE(PG8_SB(1, 1), cB + hstep + kstep, voffB);
        PG8_WAIT_V(6); PG8_BAR;
    }
    for (;;) {
        const bool has_next = S.next(ui + 1, nxt);
        const char* nA = has_next ? (const char*)g.A + (size_t)nxt.pm * tstep + (size_t)nxt.pm * kwb : cA; const char* nB = has_next ? (const char*)g.Bt + (size_t)nxt.pn * tstep + (size_t)nxt.pm * kwb : cB;
        for (int t = 0; t < nt; t += 2) {
            const bool last = (t == nt - 2);
            const char* a1 = cA + (size_t)(t + 1) * kstep;
            const char* a2 = last ? nA : cA + (size_t)(t + 2) * kstep; const char* b2 = last ? nB : cB + (size_t)(t + 2) * kstep;
            const char* a3 = a2 + kstep; const char* b3 = b2 + kstep;
            if (last && has_next) S.a_ready(nxt);
            if constexpr (SP2) {
            PG8_LDB(B0, 0, 0); PG8_LDB(B1, 0, 1); PG8_SCHED; PG8_LDA(At, 0, 0); PG8_STAGE(PG8_SA(1, 1), a1 + hstep, voffA);
            PG8_WAIT_V(8); PG8_WAIT_L(0); PG8_BAR; PG8_MMA(0, 0, At, B0); PG8_MMA(0, 1, At, B1); PG8_BAR; PG8_SCHED;
            PG8_LDA(At, 0, 1); PG8_STAGE(PG8_SB(0, 0), b2, voffB); PG8_STAGE(PG8_SB(0, 1), b2 + hstep, voffB); PG8_STAGE(PG8_SA(0, 0), a2, voffA);
            PG8_WAIT_V(8); PG8_WAIT_L(0); PG8_BAR; PG8_MMA(1, 0, At, B0); PG8_MMA(1, 1, At, B1); PG8_BAR; PG8_SCHED;
            PG8_LDB(B0, 1, 0); PG8_LDB(B1, 1, 1); PG8_SCHED; PG8_LDA(At, 1, 0); PG8_STAGE(PG8_SA(0, 1), a2 + hstep, voffA);
            PG8_WAIT_V(8); PG8_WAIT_L(0); PG8_BAR; PG8_MMA(0, 0, At, B0); PG8_MMA(0, 1, At, B1); PG8_BAR; PG8_SCHED;
            PG8_LDA(At, 1, 1); PG8_STAGE(PG8_SB(1, 0), b3, voffB); PG8_STAGE(PG8_SB(1, 1), b3 + hstep, voffB); PG8_STAGE(PG8_SA(1, 0), a3, voffA);
            PG8_WAIT_V(8); PG8_WAIT_L(0); PG8_BAR; PG8_MMA(1, 0, At, B0); PG8_MMA(1, 1, At, B1); PG8_BAR; PG8_SCHED;
            } else {
            PG8_LDB(B0, 0, 0); PG8_SCHED; PG8_LDA(At, 0, 0); PG8_STAGE(PG8_SA(1, 1), a1 + hstep, voffA);
            PG8_WAIT_L(8); PG8_BAR; PG8_WAIT_L(0); PG8_MMA(0, 0, At, B0); PG8_BAR; PG8_SCHED;
            PG8_LDB(B1, 0, 1); PG8_STAGE(PG8_SB(0, 0), b2, voffB);
            PG8_BAR; PG8_WAIT_L(0); PG8_MMA(0, 1, At, B1); PG8_BAR;
            PG8_LDA(At, 0, 1); PG8_STAGE(PG8_SA(0, 0), a2, voffA);
            PG8_BAR; PG8_WAIT_L(0); PG8_MMA(1, 0, At, B0); PG8_BAR; PG8_SCHED;
            PG8_STAGE(PG8_SB(0, 1), b2 + hstep, voffB);
            PG8_WAIT_V(6); PG8_BAR; PG8_MMA(1, 1, At, B1); PG8_BAR;
            PG8_LDB(B0, 1, 0); PG8_SCHED; PG8_LDA(At, 1, 0); PG8_STAGE(PG8_SA(0, 1), a2 + hstep, voffA);
            PG8_WAIT_L(8); PG8_BAR; PG8_WAIT_L(0); PG8_MMA(0, 0, At, B0); PG8_BAR; PG8_SCHED;
            PG8_LDB(B1, 1, 1); PG8_STAGE(PG8_SB(1, 0), b3, voffB);
            PG8_BAR; PG8_WAIT_L(0); PG8_MMA(0, 1, At, B1); PG8_BAR;
            PG8_LDA(At, 1, 1); PG8_STAGE(PG8_SA(1, 0), a3, voffA);
            PG8_BAR; PG8_WAIT_L(0); PG8_MMA(1, 0, At, B0); PG8_BAR; PG8_SCHED;
            PG8_STAGE(PG8_SB(1, 1), b3 + hstep, voffB);
            PG8_WAIT_V(6); PG8_BAR; PG8_MMA(1, 1, At, B1); PG8_BAR;
            }
        }
        if constexpr (FP8) asm volatile("s_nop 15\n\ts_nop 15" : "+v"(acc[1][1][0][0]), "+v"(acc[1][1][0][1]), "+v"(acc[1][1][1][0]), "+v"(acc[1][1][1][1]), "+v"(acc[1][1][2][0]), "+v"(acc[1][1][2][1]), "+v"(acc[1][1][3][0]), "+v"(acc[1][1][3][1]));
        if constexpr (ALIGN_EPI) { if (wr == 0) PG8_BAR; }
        if constexpr (!Epi::AFTER_DRAIN) { E(acc, cur, wr, wc, fr, fq); S.done(cur); }
        if (!has_next) break;
#pragma unroll
        for (int a = 0; a < 2; ++a)
#pragma unroll
            for (int b = 0; b < 2; ++b)
#pragma unroll
                for (int m = 0; m < 4; ++m)
#pragma unroll
                    for (int n = 0; n < 2; ++n) acc[a][b][m][n] = (f32x4){0.f, 0.f, 0.f, 0.f};
        cur = nxt; cA = nA; cB = nB; ++ui;
        if constexpr (ALIGN_EPI) { if (wr == 1) PG8_BAR; }
    }
    PG8_WAIT_V(0);
    if constexpr (!ALIGN_EPI) { if (wr == 0) PG8_BAR; }
    PG8_BAR;
    if constexpr (Epi::AFTER_DRAIN) { E.fused(acc, cur, wr, wc, fr, fq, lds, wid, lane); S.done(cur); }
#undef PG8_SA
#undef PG8_SB
#undef PG8_STAGE
#undef PG8_LDA
#undef PG8_LDB
#undef PG8_MMA
#undef PG8_WAIT_V
#undef PG8_WAIT_L
#undef PG8_BAR
#undef PG8_SCHED
}
}

namespace epi {
using pg8::f32x4; using pg8::Unit;
template <class F> struct EpiG {
    static constexpr bool PERM = true, AFTER_DRAIN = false;
    F f;
    __device__ __forceinline__ void operator()(const f32x4 (&acc)[2][2][4][2], const Unit& u, int wr, int wc, int fr, int fq) const {
        const int row0 = u.pm * 256 + wr * 64 + fr, col0 = u.pn * 256 + wc * 32 + 8 * fq;
#pragma unroll
        for (int ai = 0; ai < 2; ++ai)
#pragma unroll
            for (int m = 0; m < 4; ++m)
#pragma unroll
                for (int bj = 0; bj < 2; ++bj) f.tile8(row0 + ai * 128 + m * 16, col0 + bj * 128, acc[ai][bj][m][0], acc[ai][bj][m][1]);
    }
};
__device__ __forceinline__ v4u pack8(f32x4 a, f32x4 b) { v4u w; w.x = pk2(a[0], a[1]); w.y = pk2(a[2], a[3]); w.z = pk2(b[0], b[1]); w.w = pk2(b[2], b[3]); return w; }

struct FStoreBf16 { bf16* O; int ldc;
    __device__ __forceinline__ void tile8(int row, int col, f32x4 a, f32x4 b) const { *(v4u*)(O + (size_t)row * ldc + col) = pack8(a, b); } };

struct FStoreBf16S { bf16* O; int ldc; float sc;
    __device__ __forceinline__ void tile8(int row, int col, f32x4 a, f32x4 b) const { *(v4u*)(O + (size_t)row * ldc + col) = pack8(a * sc, b * sc); } };

struct FKVSplit { unsigned char* K8; unsigned char* VT;
    __device__ __forceinline__ void tile8(int row, int col, f32x4 a, f32x4 b) const {
        const int hh = col >> 8, c = col & 255; constexpr float sc = 1.0f / (F8S_XN * F8S_W), sk = sc * F8S_K, sv = sc * F8S_V;
        if (c < 128) { v2u o8; o8.x = pk4_f8(a[0] * sk, a[1] * sk, a[2] * sk, a[3] * sk); o8.y = pk4_f8(b[0] * sk, b[1] * sk, b[2] * sk, b[3] * sk); *(v2u*)(K8 + (size_t)row * (MLA_H * QK_NOPE) + hh * QK_NOPE + c) = o8; }
        else if (row < TOK) {
            const int bb = row / LTOK, l = row - bb * LTOK, tile = l >> 6, kk = l & 63, k5 = kk & 31;
            const int slot = ((k5 >> 2) & 1) * 32 + (kk >> 5) * 16 + (k5 & 3) + 4 * (k5 >> 3);
            unsigned char* p = VT + ((size_t)((bb * MLA_H + hh) * NTV + tile) * 128 + (c - 128)) * 64 + slot;
            const unsigned w0 = pk4_f8(a[0] * sv, a[1] * sv, a[2] * sv, a[3] * sv), w1 = pk4_f8(b[0] * sv, b[1] * sv, b[2] * sv, b[3] * sv);
            p[0] = (unsigned char)w0; p[64] = (unsigned char)(w0 >> 8); p[128] = (unsigned char)(w0 >> 16); p[192] = (unsigned char)(w0 >> 24);
            p[256] = (unsigned char)w1; p[320] = (unsigned char)(w1 >> 8); p[384] = (unsigned char)(w1 >> 16); p[448] = (unsigned char)(w1 >> 24);
        }
    } };

struct FStoreProjB { bf16* O; int ldc; float sc;
    __device__ __forceinline__ void tile8(int row, int col, f32x4 a, f32x4 b) const { *(v4u*)(O + (size_t)row * ldc + col + (col >= 1024 ? 1024 : 0)) = pack8(a * sc, b * sc); } };

struct FStoreF16 { unsigned short* O; int ldc;
    __device__ __forceinline__ void tile8(int row, int col, f32x4 a, f32x4 b) const {
        v4u w; w.x = __builtin_bit_cast(unsigned, __builtin_amdgcn_cvt_pkrtz(a[0], a[1])); w.y = __builtin_bit_cast(unsigned, __builtin_amdgcn_cvt_pkrtz(a[2], a[3]));
        w.z = __builtin_bit_cast(unsigned, __builtin_amdgcn_cvt_pkrtz(b[0], b[1])); w.w = __builtin_bit_cast(unsigned, __builtin_amdgcn_cvt_pkrtz(b[2], b[3]));
        *(v4u*)(O + (size_t)row * ldc + col) = w; } };

struct FStoreF32 { float* O; int ldc;
    __device__ __forceinline__ void tile8(int row, int col, f32x4 a, f32x4 b) const { float* p = O + (size_t)row * ldc + col; *(f32x4*)p = a; *(f32x4*)(p + 4) = b; } };

struct FQRope { unsigned char* Q; const float* cosT; const float* sinT;
    __device__ __forceinline__ void tile8(int row, int col, f32x4 a, f32x4 b) const {
        const int j = col % QK_D;
        if (j >= QK_NOPE) {
            const int l = NMETA + (row % SEQ), i0 = (j - QK_NOPE) >> 1;
            const f32x4 c = *(const f32x4*)(cosT + l * 32 + i0), s = *(const f32x4*)(sinT + l * 32 + i0);
            f32x4 ra, rb;
            ra[0] = a[0] * c[0] - a[1] * s[0]; ra[1] = a[0] * s[0] + a[1] * c[0];
            ra[2] = a[2] * c[1] - a[3] * s[1]; ra[3] = a[2] * s[1] + a[3] * c[1];
            rb[0] = b[0] * c[2] - b[1] * s[2]; rb[1] = b[0] * s[2] + b[1] * c[2];
            rb[2] = b[2] * c[3] - b[3] * s[3]; rb[3] = b[2] * s[3] + b[3] * c[3];
            a = ra; b = rb;
        }
        constexpr float QS = QSCALE * F8S_Q / (F8S_XN * F8S_W);
        v2u o8; o8.x = pk4_f8(a[0] * QS, a[1] * QS, a[2] * QS, a[3] * QS); o8.y = pk4_f8(b[0] * QS, b[1] * QS, b[2] * QS, b[3] * QS);
        *(v2u*)(Q + (size_t)row * NQ + col) = o8;
    } };

struct FLoraW { bf16* OMIC; const float* w0; const float* a0;
    __device__ __forceinline__ void tile8(int row, int col, f32x4 a, f32x4 b) const {
        const int seg = col >> 10, c = col & 1023;
        float v[8] = {a[0], a[1], a[2], a[3], b[0], b[1], b[2], b[3]};
        if (seg < 2) {
            const float* w = w0 + seg * 1024 + c;
#pragma unroll
            for (int i = 0; i < 8; ++i) { const float e = 0.6065306597126334f * sigmoidf_(w[i] + v[i]); v[i] = 1.0f - __expf(-e); }
        } else {
            const float* w = a0 + (seg - 2) * 1024 + c;
#pragma unroll
            for (int i = 0; i < 8; ++i) v[i] = sigmoidf_(w[i] + v[i]);
        }
        v4u o; o.x = pk2(v[0], v[1]); o.y = pk2(v[2], v[3]); o.z = pk2(v[4], v[5]); o.w = pk2(v[6], v[7]);
        *(v4u*)(OMIC + (size_t)seg * TP * 1024 + (size_t)row * 1024 + c) = o;
    } };

struct FGateMul { bf16* BUF; const bf16* ADD; const float* bias; unsigned char* M8;
    __device__ __forceinline__ void tile8(int row, int col, f32x4 a, f32x4 b) const {
        const size_t off = (size_t)row * DM + col; constexpr float sc = 1.0f / (F8S_XN * F8S_W); a = a * sc; b = b * sc;
        const v4u t = *(const v4u*)(BUF + off);
        const f32x4 b0 = *(const f32x4*)(bias + col), b1 = *(const f32x4*)(bias + col + 4);
        float r[8];
        r[0] = sigmoidf_(a[0] + b0[0]) * bf_lo(t.x); r[1] = sigmoidf_(a[1] + b0[1]) * bf_hi(t.x);
        r[2] = sigmoidf_(a[2] + b0[2]) * bf_lo(t.y); r[3] = sigmoidf_(a[3] + b0[3]) * bf_hi(t.y);
        r[4] = sigmoidf_(b[0] + b1[0]) * bf_lo(t.z); r[5] = sigmoidf_(b[1] + b1[1]) * bf_hi(t.z);
        r[6] = sigmoidf_(b[2] + b1[2]) * bf_lo(t.w); r[7] = sigmoidf_(b[3] + b1[3]) * bf_hi(t.w);
        if (ADD) { const v4u m = *(const v4u*)(ADD + off);
            r[0] += bf_lo(m.x); r[1] += bf_hi(m.x); r[2] += bf_lo(m.y); r[3] += bf_hi(m.y); r[4] += bf_lo(m.z); r[5] += bf_hi(m.z); r[6] += bf_lo(m.w); r[7] += bf_hi(m.w); }
        if (M8) { v2u o8; o8.x = pk4_f8(r[0] * F8S_M, r[1] * F8S_M, r[2] * F8S_M, r[3] * F8S_M); o8.y = pk4_f8(r[4] * F8S_M, r[5] * F8S_M, r[6] * F8S_M, r[7] * F8S_M); *(v2u*)(M8 + off) = o8; return; }
        v4u o; o.x = pk2(r[0], r[1]); o.y = pk2(r[2], r[3]); o.z = pk2(r[4], r[5]); o.w = pk2(r[6], r[7]);
        *(v4u*)(BUF + off) = o;
    } };

struct FGate8 { unsigned char* G8; const float* bias;
    __device__ __forceinline__ void tile8(int row, int col, f32x4 a, f32x4 b) const {
        const size_t off = (size_t)row * DM + col; constexpr float sc = 1.0f / (F8S_XN * F8S_W);
        const f32x4 b0 = *(const f32x4*)(bias + col), b1 = *(const f32x4*)(bias + col + 4);
        unsigned q[8];
#pragma unroll
        for (int i = 0; i < 4; ++i) { q[i] = (unsigned)(255.0f * sigmoidf_(a[i] * sc + b0[i]) + 0.5f); q[4 + i] = (unsigned)(255.0f * sigmoidf_(b[i] * sc + b1[i]) + 0.5f); }
        v2u o; o.x = q[0] | (q[1] << 8) | (q[2] << 16) | (q[3] << 24); o.y = q[4] | (q[5] << 8) | (q[6] << 16) | (q[7] << 24);
        *(v2u*)(G8 + off) = o;
    } };
template <int PASS> struct FMulG8 { bf16* OUT; const unsigned char* G8; const bf16* ADD; unsigned char* M8;
    __device__ __forceinline__ void tile8(int row, int col, f32x4 a, f32x4 b) const {
        const size_t off = (size_t)row * DM + col; constexpr float sc = (1.0f / 255.0f) / ((PASS == 0 ? F8S_Y : F8S_O) * F8S_W);
        const v2u gv = *(const v2u*)(G8 + off);
        float r[8];
        r[0] = (float)(gv.x & 0xffu) * (a[0] * sc); r[1] = (float)((gv.x >> 8) & 0xffu) * (a[1] * sc); r[2] = (float)((gv.x >> 16) & 0xffu) * (a[2] * sc); r[3] = (float)(gv.x >> 24) * (a[3] * sc);
        r[4] = (float)(gv.y & 0xffu) * (b[0] * sc); r[5] = (float)((gv.y >> 8) & 0xffu) * (b[1] * sc); r[6] = (float)((gv.y >> 16) & 0xffu) * (b[2] * sc); r[7] = (float)(gv.y >> 24) * (b[3] * sc);
        if (ADD) { const v4u m = *(const v4u*)(ADD + off);
            r[0] += bf_lo(m.x); r[1] += bf_hi(m.x); r[2] += bf_lo(m.y); r[3] += bf_hi(m.y); r[4] += bf_lo(m.z); r[5] += bf_hi(m.z); r[6] += bf_lo(m.w); r[7] += bf_hi(m.w); }
        if (M8) { v2u o8; o8.x = pk4_f8(r[0] * F8S_M, r[1] * F8S_M, r[2] * F8S_M, r[3] * F8S_M); o8.y = pk4_f8(r[4] * F8S_M, r[5] * F8S_M, r[6] * F8S_M, r[7] * F8S_M); *(v2u*)(M8 + off) = o8; return; }
        v4u o; o.x = pk2(r[0], r[1]); o.y = pk2(r[2], r[3]); o.z = pk2(r[4], r[5]); o.w = pk2(r[6], r[7]);
        *(v4u*)(OUT + off) = o;
    } };

struct FResid { bf16* H1; const float* x; float sc;
    __device__ __forceinline__ void tile8(int row, int col, f32x4 a, f32x4 b) const {
        const size_t off = (size_t)row * DM + col; a = a * sc; b = b * sc;
        *(v4u*)(H1 + off) = pack8(*(const f32x4*)(x + off) + a, *(const f32x4*)(x + off + 4) + b);
    } };
struct EpiResidNorm {
    static constexpr bool PERM = true, AFTER_DRAIN = false;
    bf16* N2; const bf16* xb; const float* g; float* SSQ; float sc;
    __device__ __forceinline__ void operator()(const f32x4 (&acc)[2][2][4][2], const Unit& u, int wr, int wc, int fr, int fq) const {
        const int row0 = u.pm * 256 + wr * 64 + fr, col0 = u.pn * 256 + wc * 32 + 8 * fq;
#pragma unroll
        for (int ai = 0; ai < 2; ++ai)
#pragma unroll
            for (int m = 0; m < 4; ++m) { const int row = row0 + ai * 128 + m * 16; float ss = 0.f;
#pragma unroll
                for (int bj = 0; bj < 2; ++bj) { const int col = col0 + bj * 128; const size_t off = (size_t)row * DM + col;
                    const v4u xv = *(const v4u*)(xb + off);
                    const f32x4 a = (f32x4){bf_lo(xv.x), bf_hi(xv.x), bf_lo(xv.y), bf_hi(xv.y)} + acc[ai][bj][m][0] * sc, b = (f32x4){bf_lo(xv.z), bf_hi(xv.z), bf_lo(xv.w), bf_hi(xv.w)} + acc[ai][bj][m][1] * sc;
                    const f32x4 g0 = *(const f32x4*)(g + col), g1 = *(const f32x4*)(g + col + 4);
                    *(v4u*)(N2 + off) = pack8(a * g0, b * g1);
                    ss += (a[0] * a[0] + a[1] * a[1]) + (a[2] * a[2] + a[3] * a[3]) + (b[0] * b[0] + b[1] * b[1]) + (b[2] * b[2] + b[3] * b[3]); }
                { auto r_ = __builtin_amdgcn_permlane32_swap(__float_as_uint(ss), __float_as_uint(ss), false, false); ss = __uint_as_float(r_[0]) + __uint_as_float(r_[1]); }
                { auto r_ = __builtin_amdgcn_permlane16_swap(__float_as_uint(ss), __float_as_uint(ss), false, false); ss = __uint_as_float(r_[0]) + __uint_as_float(r_[1]); }
                if (fq == 0) SSQ[(size_t)row * 32 + u.pn * 4 + wc] = ss; }
    }
};
}

namespace att {
using bf16x8 = __attribute__((ext_vector_type(8))) short;
using s16x4  = __attribute__((ext_vector_type(4))) short;
using f32x16 = __attribute__((ext_vector_type(16))) float;
using u32x4  = __attribute__((ext_vector_type(4))) unsigned;
constexpr int NW = 8, QBLK = 32, KVBLK = 64, NT = 66;
constexpr int LDQ = NQ  , LDK8 = MLA_H * QK_NOPE  , LDKR = 64  , LDO = DM;
constexpr int SHM_V = 128 * KVBLK, SHM_K = KVBLK * 128, SHM_KR = KVBLK * 64;
constexpr int OFF_V = 0, OFF_K = 2 * SHM_V, OFF_KR = OFF_K + 2 * SHM_K, OFF_WS = OFF_KR + 2 * SHM_KR, SHM_ATTN = OFF_WS + NW * 64 * 4;
constexpr float SCL = 1.0f / (F8S_Q * F8S_K);
constexpr float THRL = 0.0f, PSH = 8.0f;
typedef int i32x8 __attribute__((ext_vector_type(8)));
typedef float f32x2 __attribute__((ext_vector_type(2)));
typedef int i32x4 __attribute__((ext_vector_type(4)));
#define SBAR() __builtin_amdgcn_sched_barrier(0)
__device__ __forceinline__ int crow(int r, int hi) { return (r & 3) + 8 * (r >> 2) + 4 * hi; }
__device__ __forceinline__ unsigned cvtpk(float lo, float hi) { unsigned r; asm volatile("v_cvt_pk_bf16_f32 %0, %1, %2" : "=v"(r) : "v"(lo), "v"(hi)); return r; }

__device__ __forceinline__ void kmask(f32x16& p0, f32x16& p1, int tile, int hi) {
    const int kb = tile * KVBLK;
#pragma unroll
    for (int r = 0; r < 16; ++r) { const int k = kb + crow(r, hi); if (k >= LTOK) p0[r] = -1e30f; if (k + 32 >= LTOK) p1[r] = -1e30f; }
}
__device__ __forceinline__ void partialSM(f32x16& p0, f32x16& p1, float& m_reg, float& mn, float& alpha) {
    float pmax = p0[0];
#pragma unroll
    for (int r = 1; r < 16; ++r) pmax = fmaxf(pmax, p0[r]);
#pragma unroll
    for (int r = 0; r < 16; ++r) pmax = fmaxf(pmax, p1[r]);
    { auto rr = __builtin_amdgcn_permlane32_swap(__float_as_uint(pmax), __float_as_uint(pmax), false, false);
      pmax = fmaxf(__uint_as_float(rr[0]), __uint_as_float(rr[1])); }
    pmax *= SCL;
    if (__builtin_expect(__all(pmax - m_reg <= THRL), 1)) { mn = m_reg; alpha = 1.f; }
    else { mn = fmaxf(m_reg, pmax); alpha = __builtin_amdgcn_exp2f(m_reg - mn); m_reg = mn; }
    const float mn8 = PSH - mn; const f32x2 sc2 = {SCL, SCL}, m2 = {mn8, mn8};
#pragma unroll
    for (int r = 0; r < 16; r += 2) { f32x2 t = {p0[r], p0[r + 1]}; t = __builtin_elementwise_fma(t, sc2, m2); p0[r] = t[0]; p0[r + 1] = t[1]; }
#pragma unroll
    for (int r = 0; r < 16; r += 2) { f32x2 t = {p1[r], p1[r + 1]}; t = __builtin_elementwise_fma(t, sc2, m2); p1[r] = t[0]; p1[r + 1] = t[1]; }
#pragma unroll
    for (int r = 0; r < 16; ++r) p0[r] = __builtin_amdgcn_exp2f(p0[r]);
}
__device__ __forceinline__ void finishSM(f32x16& p0, f32x16& p1, float alpha, float& l_reg, i32x8& P8) {
#pragma unroll
    for (int r = 0; r < 16; ++r) p1[r] = __builtin_amdgcn_exp2f(p1[r]);
    f32x2 ps2 = {p0[0], p0[1]};
#pragma unroll
    for (int r = 2; r < 16; r += 2) ps2 += (f32x2){p0[r], p0[r + 1]};
#pragma unroll
    for (int r = 0; r < 16; r += 2) ps2 += (f32x2){p1[r], p1[r + 1]};
    float ps = ps2[0] + ps2[1];
    { auto rr = __builtin_amdgcn_permlane32_swap(__float_as_uint(ps), __float_as_uint(ps), false, false);
      ps = __uint_as_float(rr[0]) + __uint_as_float(rr[1]); }
    l_reg = l_reg * alpha + ps;
#pragma unroll
    for (int w = 0; w < 4; ++w) { int x = __builtin_amdgcn_cvt_pk_fp8_f32(p0[4 * w], p0[4 * w + 1], 0, false); P8[w] = __builtin_amdgcn_cvt_pk_fp8_f32(p0[4 * w + 2], p0[4 * w + 3], x, true); }
#pragma unroll
    for (int w = 0; w < 4; ++w) { int x = __builtin_amdgcn_cvt_pk_fp8_f32(p1[4 * w], p1[4 * w + 1], 0, false); P8[4 + w] = __builtin_amdgcn_cvt_pk_fp8_f32(p1[4 * w + 2], p1[4 * w + 3], x, true); }
}
template <int OFF> __device__ __forceinline__ bf16x8 lds_rd128(int addr) { bf16x8 r; asm volatile("ds_read_b128 %0, %1 offset:%2" : "=&v"(r) : "v"(addr), "i"(OFF) : "memory"); return r; }
#define LGKM_WAIT(n) asm volatile("s_waitcnt lgkmcnt(" #n ")" ::: "memory")
__device__ __forceinline__ void attn_unit(int b, int h, int q0, const unsigned char* __restrict__ Q8, const unsigned char* __restrict__ K8, const unsigned char* __restrict__ VT, const unsigned char* __restrict__ KR8, bf16* __restrict__ O, char* lds) {
    int tid_ = threadIdx.x; asm volatile("" : "+v"(tid_));
    const int tid = tid_, wid = __builtin_amdgcn_readfirstlane(tid >> 6), lane = tid & 63, r32 = lane & 31, hi = lane >> 5;
    char* V_lds = lds + OFF_V; char* K_lds = lds + OFF_K; char* KR_lds = lds + OFF_KR;
    float* ws = (float*)(lds + OFF_WS) + wid * 64; float* li_l = ws; float* al_l = ws + 32;
    float m_reg = -1e30f, l_reg = 0; f32x16 o[4] = {};
    const long kbase = (long)b * LTOK;
    const long rbase = (long)b * SEQ + q0 + wid * QBLK;
    i32x8 q8[3];
    { const unsigned char* Qw = Q8 + (rbase + r32) * LDQ + h * QK_D + hi * 32;
#pragma unroll
      for (int t = 0; t < 3; ++t) { const i32x4 lo = *reinterpret_cast<const i32x4*>(Qw + t * 64), hh = *reinterpret_cast<const i32x4*>(Qw + t * 64 + 16); q8[t] = (i32x8){lo[0], lo[1], lo[2], lo[3], hh[0], hh[1], hh[2], hh[3]}; } }
    const unsigned char* Kh = K8 + kbase * LDK8 + h * QK_NOPE; const unsigned char* Vh = VT + (size_t)(b * MLA_H + h) * NTV * SHM_V; const unsigned char* KRb = KR8 + kbase * LDKR;
    const int v_lds0 = (int)(uintptr_t)V_lds, k_lds0 = (int)(uintptr_t)K_lds, kr_lds0 = (int)(uintptr_t)KR_lds;
    int koff, voff, roff;
    { const int P = wid * 64 + lane, row = P >> 3, c = (P & 7) ^ (row & 7); koff = row * LDK8 + c * 16; }
    { const int P = wid * 64 + lane, d = P >> 2, c = (P & 3) ^ ((d >> 1) & 3); voff = d * 64 + c * 16; }
    { const int P = (wid & 3) * 64 + lane, row = P >> 2, c = (P & 3) ^ ((row >> 1) & 3); roff = row * LDKR + c * 16; }
    typedef __attribute__((address_space(3))) unsigned lds_u32;
#define DMA(t, bb) do { const unsigned char* kt_ = Kh + (long)(t) * KVBLK * LDK8; const unsigned char* vt_ = Vh + (long)(t) * SHM_V; const unsigned char* rt_ = KRb + (long)(t) * KVBLK * LDKR; \
    __builtin_amdgcn_global_load_lds((const unsigned*)(kt_ + koff), (lds_u32*)(K_lds + (bb) * SHM_K + wid * 1024), 16, 0, 0); \
    __builtin_amdgcn_global_load_lds((const unsigned*)(vt_ + voff), (lds_u32*)(V_lds + (bb) * SHM_V + wid * 1024), 16, 0, 0); \
    if (wid < 4) __builtin_amdgcn_global_load_lds((const unsigned*)(rt_ + roff), (lds_u32*)(KR_lds + (bb) * SHM_KR + wid * 1024), 16, 0, 0); } while (0)
#define RESC(a) do { if (__any((a) < 1.f)) { if (hi == 0) al_l[r32] = (a); asm volatile("s_waitcnt lgkmcnt(0)" ::: "memory"); \
    _Pragma("unroll") for (int d = 0; d < 4; ++d) _Pragma("unroll") for (int r = 0; r < 16; ++r) o[d][r] *= al_l[crow(r, hi)]; } } while (0)
    f32x16 p0, p1; float mn, al; i32x8 P8;
    DMA(0, 0);
    for (int j = 0; j < NT; ++j) {
        const int bb = j & 1;
        asm volatile("s_waitcnt vmcnt(0)" ::: "memory"); __syncthreads();
        if (j + 1 < NT) DMA(j + 1, bb ^ 1);
        int r32o = r32, hio = hi; asm volatile("" : "+v"(r32o), "+v"(hio));
        const int kad = k_lds0 + bb * SHM_K + r32o * 128 + ((hio * 32) ^ ((r32o & 7) << 4)), rad = kr_lds0 + bb * SHM_KR + r32o * 64 + ((hio * 32) ^ (((r32o >> 1) & 3) << 4));
        const int vad = v_lds0 + bb * SHM_V + r32o * 64 + ((hio * 32) ^ (((r32o >> 1) & 3) << 4)), vad1 = vad ^ 16;
        bf16x8 vf[4][2];
        bf16x8 f0[3][2], f1[3][2];
        { const int a0 = kad, a1 = kad ^ 16, a2 = kad ^ 64, a3 = kad ^ 64 ^ 16, a4 = rad, a5 = rad ^ 16;
          f0[0][0] = lds_rd128<0>(a0); f0[0][1] = lds_rd128<0>(a1); f1[0][0] = lds_rd128<32 * 128>(a0); f1[0][1] = lds_rd128<32 * 128>(a1);
          f0[1][0] = lds_rd128<0>(a2); f0[1][1] = lds_rd128<0>(a3); f1[1][0] = lds_rd128<32 * 128>(a2); f1[1][1] = lds_rd128<32 * 128>(a3);
          f0[2][0] = lds_rd128<0>(a4); f0[2][1] = lds_rd128<0>(a5); f1[2][0] = lds_rd128<32 * 64>(a4); f1[2][1] = lds_rd128<32 * 64>(a5); }
#define CAT8(x, y) ({ const i32x4 x_ = __builtin_bit_cast(i32x4, (x)), y_ = __builtin_bit_cast(i32x4, (y)); (i32x8){x_[0], x_[1], x_[2], x_[3], y_[0], y_[1], y_[2], y_[3]}; })
#define MMK(t_) do { p0 = __builtin_amdgcn_mfma_scale_f32_32x32x64_f8f6f4(CAT8(f0[t_][0], f0[t_][1]), q8[t_], p0, 0, 0, 0, 0, 0, 0); \
                     p1 = __builtin_amdgcn_mfma_scale_f32_32x32x64_f8f6f4(CAT8(f1[t_][0], f1[t_][1]), q8[t_], p1, 0, 0, 0, 0, 0, 0); } while (0)
        p0 = f32x16{}; p1 = f32x16{};
        LGKM_WAIT(8); SBAR(); MMK(0); SBAR();
        vf[0][0] = lds_rd128<0>(vad); vf[0][1] = lds_rd128<0>(vad1); vf[1][0] = lds_rd128<2048>(vad); vf[1][1] = lds_rd128<2048>(vad1);
        LGKM_WAIT(8); SBAR(); MMK(1); SBAR();
        LGKM_WAIT(4); SBAR(); MMK(2); SBAR();
#undef MMK
        if (j >= 64) kmask(p0, p1, j, hi);
        partialSM(p0, p1, m_reg, mn, al);
        finishSM(p0, p1, al, l_reg, P8); SBAR();
        RESC(al);
        LGKM_WAIT(0);
        vf[2][0] = lds_rd128<4096>(vad); vf[2][1] = lds_rd128<4096>(vad1); vf[3][0] = lds_rd128<6144>(vad); vf[3][1] = lds_rd128<6144>(vad1);
#define PVM(d_) o[d_] = __builtin_amdgcn_mfma_scale_f32_32x32x64_f8f6f4(P8, CAT8(vf[d_][0], vf[d_][1]), o[d_], 0, 0, 0, 0, 0, 0)
        SBAR(); PVM(0); PVM(1); SBAR();
        LGKM_WAIT(0); SBAR(); PVM(2); PVM(3); SBAR();
#undef PVM
    }
    if (hi == 0) li_l[r32] = l_reg; asm volatile("s_waitcnt lgkmcnt(0)" ::: "memory");
    float rli[16];
#pragma unroll
    for (int r = 0; r < 16; ++r) rli[r] = __builtin_amdgcn_rcpf(li_l[crow(r, hi)] * F8S_V);
    int hie = hi; asm volatile("" : "+v"(hie));
    unsigned char* Ow = (unsigned char*)O + rbase * LDO + h * V_D + r32;
#pragma unroll
    for (int r = 0; r < 16; ++r) { const int orow = crow(r, hie);
#pragma unroll
        for (int d0 = 0; d0 < 4; ++d0) { const float v = f8c(o[d0][r] * (rli[r] * F8S_O)); Ow[orow * LDO + d0 * 32] = (unsigned char)__builtin_amdgcn_cvt_pk_fp8_f32(v, v, 0, false); } }
    __syncthreads();
#undef DMA
#undef RESC
#undef CAT8
#undef LGKM_WAIT
}
#undef KSWZ
#undef KRSWZ
#undef SBAR
}

struct Ctx { int tid, lane, wave, G, vcu, gw, NGW; LAS unsigned char* lds; };

template <int MODE> __device__ __forceinline__ int map_row(int n, int row_off) {
    if (MODE == 1) { if (n < 1024) return row_off + n; const int m = n - 1024; return row_off + 1024 + (m < 416 ? m : (m < 1440 ? m + 96 : m - 1024)); }
    if (MODE == 2) { const int h = n / QK_D, j = n - h * QK_D; if (j < QK_NOPE) return n; const int i = j - QK_NOPE; return h * QK_D + QK_NOPE + ((i < 32) ? 2 * i : 2 * (i - 32) + 1); }
    return n + row_off;
}
template <int MODE, bool F8 = false> __device__ __forceinline__ void transpose_item(const float* W, int ldw, int col_src0, int K, int nblk, bf16* WT, int row_off, LAS float* scr, int item, int lane) {
    const int kb = item / nblk, nb = item % nblk, k0 = 64 * kb, n0 = 32 * nb;
#pragma unroll 8
    for (int i = 0; i < 32; ++i) { const int kk = 2 * i + (lane >> 5); scr[kk * 33 + (lane & 31)] = W[(size_t)(k0 + kk) * ldw + col_src0 + n0 + (lane & 31)]; }
    LDS_WAIT(); asm volatile("" ::: "memory");
    const int c = lane & 7;
#pragma unroll
    for (int j = 0; j < 4; ++j) { const int n = (lane >> 3) + 8 * j; const LAS float* s = scr + (8 * c) * 33 + n;
        if constexpr (F8) {
            v2u o8; o8.x = pk4_f8(s[0 * 33] * F8S_W, s[1 * 33] * F8S_W, s[2 * 33] * F8S_W, s[3 * 33] * F8S_W); o8.y = pk4_f8(s[4 * 33] * F8S_W, s[5 * 33] * F8S_W, s[6 * 33] * F8S_W, s[7 * 33] * F8S_W);
            *(v2u*)((unsigned char*)WT + (size_t)map_row<MODE>(n0 + n, row_off) * K + k0 + 8 * c) = o8; continue; }
        v4u o; o.x = pk2(s[0 * 33], s[1 * 33]); o.y = pk2(s[2 * 33], s[3 * 33]); o.z = pk2(s[4 * 33], s[5 * 33]); o.w = pk2(s[6 * 33], s[7 * 33]);
        *(v4u*)(WT + (size_t)map_row<MODE>(n0 + n, row_off) * K + k0 + 8 * c) = o; }
    LDS_WAIT(); asm volatile("" ::: "memory");
}

constexpr int DI_G = 32 * 128, DI_UQ = 8 * 96, DI_UKV = 8 * 128, DI_PR = 16 * 64, DI_PM = 32 * 64, DI_O = 32 * 64, NDEF = DI_G + DI_UQ + DI_UKV + DI_PR + DI_PM + DI_O;
struct DefItem { const float* W; unsigned char* WT; int ldw, col0, K, k0, n0, rope; };
__device__ __forceinline__ void def_decode(const Args& a, int d, DefItem& it) {
    unsigned char* ws = a.ws; int r = d, nblk; it.rope = 0;
    if (r < DI_G) { it.W = a.in[I_WIN]; it.ldw = 8672; it.col0 = 4576; it.K = DM; nblk = 128; it.WT = ws + WS_WG; }
    else if ((r -= DI_G) < DI_UQ) { it.W = a.in[I_WUQ]; it.ldw = NQ; it.col0 = 0; it.K = 512; nblk = 96; it.WT = ws + WS_WUQ; it.rope = 1; }
    else if ((r -= DI_UQ) < DI_UKV) { it.W = a.in[I_WUKV]; it.ldw = NKV; it.col0 = 0; it.K = 512; nblk = 128; it.WT = ws + WS_WUKV; }
    else if ((r -= DI_UKV) < DI_PR) { it.W = a.in[I_PRW]; it.ldw = DM; it.col0 = 0; it.K = 1024; nblk = 64; it.WT = ws + WS_WPR; }
    else if ((r -= DI_PR) < DI_PM) { it.W = a.in[I_PMLA]; it.ldw = DM; it.col0 = 0; it.K = 2048; nblk = 64; it.WT = ws + WS_WPM; }
    else { r -= DI_PM; it.W = a.in[I_WO]; it.ldw = DM; it.col0 = 0; it.K = 2048; nblk = 64; it.WT = ws + WS_WO; }
    const int kb = r / nblk, nb = r - kb * nblk; it.k0 = 64 * kb; it.n0 = 32 * nb;
}
__device__ __forceinline__ void def_issue(const DefItem& it, int lane, float (&tv)[32]) {
#pragma unroll
    for (int i = 0; i < 32; ++i) { const int kk = 2 * i + (lane >> 5); tv[i] = it.W[(size_t)(it.k0 + kk) * it.ldw + it.col0 + it.n0 + (lane & 31)]; }
}
__device__ __forceinline__ void def_finish(const DefItem& it, LAS float* scr, int lane, const float (&tv)[32]) {
#pragma unroll
    for (int i = 0; i < 32; ++i) { const int kk = 2 * i + (lane >> 5); scr[kk * 33 + (lane & 31)] = tv[i]; }
    LDS_WAIT(); asm volatile("" ::: "memory");
    const int c = lane & 7;
#pragma unroll
    for (int j = 0; j < 4; ++j) { const int n = (lane >> 3) + 8 * j; const LAS float* s = scr + (8 * c) * 33 + n;
        v2u o8; o8.x = pk4_f8(s[0 * 33] * F8S_W, s[1 * 33] * F8S_W, s[2 * 33] * F8S_W, s[3 * 33] * F8S_W); o8.y = pk4_f8(s[4 * 33] * F8S_W, s[5 * 33] * F8S_W, s[6 * 33] * F8S_W, s[7 * 33] * F8S_W);
        const int row = it.rope ? map_row<2>(it.n0 + n, 0) : it.n0 + n;
        *(v2u*)(it.WT + (size_t)row * it.K + it.k0 + 8 * c) = o8; }
    LDS_WAIT(); asm volatile("" ::: "memory");
}

__device__ __forceinline__ void xn_row(const Args& a, const Ctx& C, int m, const float* g, bf16* XN, bf16* XNR, unsigned char* XN8T) {
    unsigned long long* o8 = (unsigned long long*)(XN + (size_t)m * DM) + C.lane;
    unsigned* t8 = (unsigned*)(XN8T + (size_t)m * DM) + C.lane;
    if (m >= TOK) {
#pragma unroll
        for (int j = 0; j < 8; ++j) { o8[64 * j] = 0ull; t8[64 * j] = 0u; }
        return; }
    const int bb = m / LTOK, l = m - bb * LTOK;
    const float* src = (l < NMETA) ? a.in[I_META] + (size_t)l * DM : a.in[I_X] + ((size_t)bb * SEQ + (l - NMETA)) * DM;
    const f32x4v* xr = (const f32x4v*)src + C.lane; const f32x4v* gr = (const f32x4v*)g + C.lane;
    f32x4v v[8]; float s = 0.f;
#pragma unroll
    for (int j = 0; j < 8; ++j) { v[j] = xr[64 * j]; s += (v[j].x * v[j].x + v[j].y * v[j].y) + (v[j].z * v[j].z + v[j].w * v[j].w); }
    const float rstd = 1.0f / sqrtf(wave_sum(s) * (1.f / DM) + NORM_EPS);
    unsigned* r8 = (l >= NMETA) ? (unsigned*)((unsigned char*)XNR + ((size_t)bb * SEQ + (l - NMETA)) * DM) + C.lane : nullptr;
#pragma unroll
    for (int j = 0; j < 8; ++j) { const f32x4v gg = gr[64 * j]; const float e0 = v[j].x * rstd * gg.x, e1 = v[j].y * rstd * gg.y, e2 = v[j].z * rstd * gg.z, e3 = v[j].w * rstd * gg.w;
        o8[64 * j] = (unsigned long long)pk2(e0, e1) | ((unsigned long long)pk2(e2, e3) << 32);
        const unsigned w8 = pk4_f8(e0 * F8S_XN, e1 * F8S_XN, e2 * F8S_XN, e3 * F8S_XN); t8[64 * j] = w8; if (r8) r8[64 * j] = w8; }
}

__device__ __forceinline__ void xn_row_real(const Args& a, const Ctx& C, int r, const float* g, bf16* XN) {
    unsigned long long* o8 = (unsigned long long*)(XN + (size_t)r * DM) + C.lane;
    const f32x4v* xr = (const f32x4v*)(a.in[I_X] + (size_t)r * DM) + C.lane; const f32x4v* gr = (const f32x4v*)g + C.lane;
    f32x4v v[8]; float s = 0.f;
#pragma unroll
    for (int j = 0; j < 8; ++j) { v[j] = xr[64 * j]; s += (v[j].x * v[j].x + v[j].y * v[j].y) + (v[j].z * v[j].z + v[j].w * v[j].w); }
    const float rstd = 1.0f / sqrtf(wave_sum(s) * (1.f / DM) + NORM_EPS);
#pragma unroll
    for (int j = 0; j < 8; ++j) { const f32x4v gg = gr[64 * j];
        o8[64 * j] = (unsigned long long)pk2(v[j].x * rstd * gg.x, v[j].y * rstd * gg.y) | ((unsigned long long)pk2(v[j].z * rstd * gg.z, v[j].w * rstd * gg.w) << 32); }
}

__device__ __forceinline__ void sincos_acc(float ang, float& s, float& c) {
    const double a = (double)ang;
    const double kq = rint(a * 0.6366197723675814);
    const double r = (a - kq * 1.5707963267948966) - kq * 6.123233995736766e-17;
    const int q = ((int)kq) & 3;
    const double r2 = r * r;
    const double sp = r * (1.0 + r2 * (-1.6666666666666666e-1 + r2 * (8.333333333333333e-3 + r2 * (-1.984126984126984e-4 + r2 * (2.7557319223985893e-6 + r2 * (-2.505210838544172e-8))))));
    const double cp = 1.0 + r2 * (-0.5 + r2 * (4.1666666666666664e-2 + r2 * (-1.388888888888889e-3 + r2 * (2.48015873015873e-5 + r2 * (-2.755731922398589e-7 + r2 * 2.08767569878681e-9)))));
    const double sv = (q & 1) ? cp : sp, cv = (q & 1) ? sp : cp;
    s = (float)((q & 2) ? -sv : sv); c = (float)(((q + 1) & 2) ? -cv : cv);
}

__device__ __forceinline__ void p0_prologue(const Args& a, const Ctx& C) {
    unsigned char* ws = a.ws;
    LAS float* scr = (LAS float*)(C.lds + C.wave * 16384);
    constexpr int I_IN = 32 * 32, I_INR = 32 * 32, I_INB = 32 * 79, NIT = I_IN + I_INR + I_INB;
    for (int it = C.gw; it < NIT; it += C.NGW) {
        int r = it;
        if (r < I_IN) { transpose_item<0>(a.in[I_WIN], 8672, 1024, DM, 32, (bf16*)(ws + WS_WIN), 0, scr, r, C.lane); continue; } r -= I_IN;
        if (r < I_INR) { transpose_item<0, true>(a.in[I_WIN], 8672, 0, DM, 32, (bf16*)(ws + WS_WIN8), 0, scr, r, C.lane); continue; } r -= I_INR;
        transpose_item<1, true>(a.in[I_WIN], 8672, 2048, DM, 79, (bf16*)(ws + WS_WIN8), 1024, scr, r, C.lane);
    }
    const long gt = (long)C.gw * 64 + C.lane, NGT = (long)C.NGW * 64;
    {
        unsigned char* W = ws + WS_WIN8;
        for (long i = gt; i < 32L * 128; i += NGT) { const int rr = (int)(i >> 7), c16 = (int)(i & 127); *(v4u*)(W + (size_t)(2528 + rr) * DM + c16 * 16) = (v4u){0u, 0u, 0u, 0u}; }
    }
    {
        bf16* Wg = (bf16*)(ws + WS_WLG); bf16* Ww = (bf16*)(ws + WS_WLW);
        for (long i = gt; i < 5120L * 32; i += NGT) { const int n = (int)(i >> 5), k0 = (int)(i & 31) * 8; const int seg = n >> 10, nn = n & 1023;
            float v[8];
#pragma unroll
            for (int e = 0; e < 8; ++e) { const int k = k0 + e; float x = 0.f;
                if (seg == 0) { if (k < 160) x = a.in[I_GUP][(size_t)k * 1024 + nn]; }
                else { const int sl = seg - 1, kk = k - 64 * sl; if (kk >= 0 && kk < 64) x = (sl < 2 ? a.in[I_WUP] : a.in[I_AUP])[(size_t)(64 * (sl & 1) + kk) * 1024 + nn]; }
                v[e] = x; }
            v4u o; o.x = pk2(v[0], v[1]); o.y = pk2(v[2], v[3]); o.z = pk2(v[4], v[5]); o.w = pk2(v[6], v[7]);
            if (seg == 0) *(v4u*)(Wg + (size_t)nn * 256 + k0) = o; else *(v4u*)(Ww + (size_t)(n - 1024) * 256 + k0) = o; }
    }
    {
        bf16* A = (bf16*)(ws + WS_AFULL); bf16* Wq = (bf16*)(ws + WS_WQBF);
        for (long i = gt; i < 2048L * 256; i += NGT) { const int row = (int)(i >> 8), c0 = (int)(i & 255) * 8; const int hp = row >> 7, n = row & 127;
            v4u o = (v4u){0u, 0u, 0u, 0u};
            if ((c0 >> 7) == hp) { const float* s = a.in[I_PKEYS] + ((size_t)hp * 128 + n) * 128 + (c0 & 127); const f32x4v x = *(const f32x4v*)s, y = *(const f32x4v*)(s + 4);
                o.x = pk2(x.x, x.y); o.y = pk2(x.z, x.w); o.z = pk2(y.x, y.y); o.w = pk2(y.z, y.w); }
            *(v4u*)(A + (size_t)row * DM + c0) = o;
            const float* s2 = a.in[I_PWQ] + (size_t)row * DM + c0; const f32x4v x = *(const f32x4v*)s2, y = *(const f32x4v*)(s2 + 4);
            v4u q; q.x = pk2(x.x, x.y); q.y = pk2(x.z, x.w); q.z = pk2(y.x, y.y); q.w = pk2(y.z, y.w);
            *(v4u*)(Wq + (size_t)row * DM + c0) = q; }
    }
    {
        float* ct = (float*)(ws + WS_ROPE); float* st = (float*)(ws + WS_ROPE + MiB);
        for (long i = gt; i < (long)LTOK * 32; i += NGT) { const int l = (int)(i >> 5), f = (int)(i & 31);
            const float inv = (float)exp2(-(double)f * (13.287712379549449 / 32.0));
            const float ang = (float)l * inv; float s, c; sincos_acc(ang, s, c); ct[i] = c; st[i] = s; }
    }
    for (int m = C.gw; m < TP; m += C.NGW) xn_row(a, C, m, a.in[I_NMG], (bf16*)(ws + WS_XN), (bf16*)a.out, ws + WS_XN8T);
}

__device__ __forceinline__ void p2_mla_prep(const Args& a, const Ctx& C) {
    unsigned char* ws = a.ws;
    const bf16* P = (const bf16*)(ws + WS_PROJ); bf16* QN = (bf16*)(ws + WS_QN); bf16* KVN = (bf16*)(ws + WS_KVN); bf16* KR = (bf16*)(ws + WS_KR);
    const float* ct = (const float*)(ws + WS_ROPE); const float* st = (const float*)(ws + WS_ROPE + MiB);
    constexpr int RB = 4;
    for (int m0 = C.gw; m0 < TP; m0 += RB * C.NGW) {
        v4u tq[RB], tk[RB]; unsigned short k1[RB], k2[RB]; float cc[RB], ss[RB];
#pragma unroll
        for (int i = 0; i < RB; ++i) { const int m = m0 + i * C.NGW; if (m < TP) { const bf16* pr = P + (size_t)m * NPROJ;
            tq[i] = *(const v4u*)(pr + C_QD + C.lane * 8); tk[i] = *(const v4u*)(pr + C_KVD + C.lane * 8);
            const int l = (m < TOK) ? m % LTOK : 0; const int lr = C.lane & 31;
            k1[i] = pr[C_KR + lr]; k2[i] = pr[C_KR + 32 + lr]; cc[i] = ct[l * 32 + lr]; ss[i] = st[l * 32 + lr]; } }
#pragma unroll
        for (int i = 0; i < RB; ++i) { const int m = m0 + i * C.NGW; if (m < TP) {
#pragma unroll
            for (int which = 0; which < 2; ++which) {
                const v4u t = which ? tk[i] : tq[i];
                float v[8] = {bf_lo(t.x), bf_hi(t.x), bf_lo(t.y), bf_hi(t.y), bf_lo(t.z), bf_hi(t.z), bf_lo(t.w), bf_hi(t.w)};
                float s = 0.f;
#pragma unroll
                for (int e = 0; e < 8; ++e) s += v[e] * v[e];
                const float rstd = 1.0f / sqrtf(wave_sum(s) * (1.f / 512.f) + NORM_EPS);
                const float* g = a.in[which ? I_KVNG : I_QNG] + C.lane * 8;
                const float rs8 = rstd * F8S_XN;
                v2u o; o.x = pk4_f8(v[0] * rs8 * g[0], v[1] * rs8 * g[1], v[2] * rs8 * g[2], v[3] * rs8 * g[3]); o.y = pk4_f8(v[4] * rs8 * g[4], v[5] * rs8 * g[5], v[6] * rs8 * g[6], v[7] * rs8 * g[7]);
                if (which) *(v2u*)((unsigned char*)KVN + (size_t)m * 512 + C.lane * 8) = o;
                else if (m < TOK) { const int bb = m / LTOK, l = m - bb * LTOK; if (l >= NMETA) *(v2u*)((unsigned char*)QN + ((size_t)bb * SEQ + (l - NMETA)) * 512 + C.lane * 8) = o; }
            }
            if (C.lane < 32) {
                const float x1 = bf2f(k1[i]), x2 = bf2f(k2[i]);
                *(unsigned short*)((unsigned char*)KR + (size_t)m * 64 + 2 * C.lane) = (unsigned short)__builtin_amdgcn_cvt_pk_fp8_f32(f8c((x1 * cc[i] - x2 * ss[i]) * F8S_K), f8c((x1 * ss[i] + x2 * cc[i]) * F8S_K), 0, false);
            } } }
    }
}

__device__ __forceinline__ void final_norm_rows(const Args& a, const Ctx& C, const float* H) {
    const float* g = a.in[I_FNG];
    for (int r = C.gw; r < BATCH * SEQ; r += C.NGW) {
        const int bb = r / SEQ, t = r - bb * SEQ, m = bb * LTOK + NMETA + t;
        const f32x4v* xr = (const f32x4v*)(H + (size_t)m * DM) + C.lane; const f32x4v* gr = (const f32x4v*)g + C.lane;
        f32x4v v[8]; float s = 0.f;
#pragma unroll
        for (int j = 0; j < 8; ++j) { v[j] = xr[64 * j]; s += (v[j].x * v[j].x + v[j].y * v[j].y) + (v[j].z * v[j].z + v[j].w * v[j].w); }
        const float rstd = 1.0f / sqrtf(wave_sum(s) * (1.f / DM) + NORM_EPS);
        f32x4v* o = (f32x4v*)(a.out + (size_t)r * DM) + C.lane;
#pragma unroll
        for (int j = 0; j < 8; ++j) { const f32x4v gg = gr[64 * j]; o[64 * j] = v[j] * rstd * gg; }
    }
}

__device__ __forceinline__ void p2_rwkv_prep(const Args& a, const Ctx& C) {
    unsigned char* ws = a.ws;
    const bf16* P = (const bf16*)(ws + WS_PROJ); bf16* RKV = (bf16*)(ws + WS_RKV); bf16* AW = (bf16*)(ws + WS_AW); bf16* AG = (bf16*)(ws + WS_AG);
    const float* sc = a.in[I_SHIFT];
    constexpr int RS = 8, NSTRIP = TP / RS;
    for (int item = C.gw; item < NSTRIP * 7; item += C.NGW) {
        const int strip = item / 7, it = item - strip * 7;
        const int ch = it * 64 + C.lane, c0 = ch * 8;
        if (ch >= 448) continue;
        const int m0 = strip * RS;
        if (ch >= 436) {
#pragma unroll 1
            for (int q = 0; q < RS; ++q) { const int m = m0 + q; if (m < TOK) { const int bb = m / LTOK, l = m - bb * LTOK; if (l >= NMETA) *(v4u*)(AG + ((size_t)bb * SEQ + (l - NMETA)) * 256 + 160 + (ch - 436) * 8) = (v4u){0u, 0u, 0u, 0u}; } }
            continue; }
        const f32x4v s0a = *(const f32x4v*)(sc + c0), s0b = *(const f32x4v*)(sc + c0 + 4);
        const f32x4v s1a = *(const f32x4v*)(sc + 3488 + c0), s1b = *(const f32x4v*)(sc + 3488 + c0 + 4);
        const f32x4v s2a = *(const f32x4v*)(sc + 2 * 3488 + c0), s2b = *(const f32x4v*)(sc + 2 * 3488 + c0 + 4);
        const v4u zero4 = (v4u){0u, 0u, 0u, 0u};
        v4u rowv[RS + 2];
#pragma unroll
        for (int q = 0; q < RS + 2; ++q) { const int m = m0 - 1 + q; rowv[q] = (m >= 0 && m < TOK) ? *(const v4u*)(P + (size_t)m * NPROJ + c0) : zero4; }
#pragma unroll
        for (int q = 0; q < RS; ++q) {
            const int m = m0 + q;
            const v4u pv = rowv[q], cu = rowv[q + 1], nv = rowv[q + 2];
            const bool valid = m < TOK; const int bb = valid ? m / LTOK : 0, l = m - bb * LTOK;
            const v4u pz = (valid && l > 0) ? pv : zero4, nz = (valid && l < LTOK - 1) ? nv : zero4;
            v4u o = zero4;
            if (valid) {
                float x[8];
                x[0] = s0a.x * bf_lo(pz.x) + s1a.x * bf_lo(cu.x) + s2a.x * bf_lo(nz.x); x[1] = s0a.y * bf_hi(pz.x) + s1a.y * bf_hi(cu.x) + s2a.y * bf_hi(nz.x);
                x[2] = s0a.z * bf_lo(pz.y) + s1a.z * bf_lo(cu.y) + s2a.z * bf_lo(nz.y); x[3] = s0a.w * bf_hi(pz.y) + s1a.w * bf_hi(cu.y) + s2a.w * bf_hi(nz.y);
                x[4] = s0b.x * bf_lo(pz.z) + s1b.x * bf_lo(cu.z) + s2b.x * bf_lo(nz.z); x[5] = s0b.y * bf_hi(pz.z) + s1b.y * bf_hi(cu.z) + s2b.y * bf_hi(nz.z);
                x[6] = s0b.z * bf_lo(pz.w) + s1b.z * bf_lo(cu.w) + s2b.z * bf_lo(nz.w); x[7] = s0b.w * bf_hi(pz.w) + s1b.w * bf_hi(cu.w) + s2b.w * bf_hi(nz.w);
                if (ch >= 384 && ch < 404) {
#pragma unroll
                    for (int e = 0; e < 8; ++e) x[e] = sigmoidf_(x[e]);
                } else if (ch >= 404 && ch < 420) {
#pragma unroll
                    for (int e = 0; e < 8; ++e) x[e] = 1.0f - 2.0f / (1.0f + __expf(2.0f * x[e]));
                }
                o.x = pk2(x[0], x[1]); o.y = pk2(x[2], x[3]); o.z = pk2(x[4], x[5]); o.w = pk2(x[6], x[7]);
            }
            if (ch < 384) *(v4u*)(RKV + (size_t)m * 3072 + c0) = o;
            else if (ch < 404) { if (valid && l >= NMETA) *(v4u*)(AG + ((size_t)bb * SEQ + (l - NMETA)) * 256 + (ch - 384) * 8) = o; }
            else *(v4u*)(AW + (size_t)m * 256 + (ch - 404) * 8) = o;
        }
    }
}

struct TabRow { f32x4v x[8]; };
__device__ __forceinline__ void tab_issue(const Args& a, int rw, int lane, TabRow& t) {
    const bool second = rw >= 16384; const int e = second ? rw - 16384 : rw;
    const float* src = a.in[second ? I_PV : I_PU] + (size_t)e * DM + lane * 4;
#pragma unroll
    for (int j = 0; j < 8; ++j) t.x[j] = *(const f32x4v*)(src + j * 256);
}
__device__ __forceinline__ void tab_finish(const Args& a, int rw, int lane, const TabRow& t) {
    const bool second = rw >= 16384; const int e = second ? rw - 16384 : rw;
    float mx = 0.f;
#pragma unroll
    for (int j = 0; j < 8; ++j) mx = fmaxf(mx, fmaxf(fmaxf(fabsf(t.x[j].x), fabsf(t.x[j].y)), fmaxf(fabsf(t.x[j].z), fabsf(t.x[j].w))));
    const unsigned sb = pk2(fmaxf(mx, 1e-30f) * (1.0f / 6.0f), 0.f) & 0xffffu;
    const float inv = 1.0f / bf_lo(sb);
    v4u o;
#pragma unroll
    for (int m = 0; m < 4; ++m) { unsigned w = 0u;
        w = __builtin_amdgcn_cvt_scalef32_pk_fp4_f32(w, t.x[2 * m][0] * inv, t.x[2 * m + 1][0] * inv, 1.0f, 0);
        w = __builtin_amdgcn_cvt_scalef32_pk_fp4_f32(w, t.x[2 * m][1] * inv, t.x[2 * m + 1][1] * inv, 1.0f, 1);
        w = __builtin_amdgcn_cvt_scalef32_pk_fp4_f32(w, t.x[2 * m][2] * inv, t.x[2 * m + 1][2] * inv, 1.0f, 2);
        w = __builtin_amdgcn_cvt_scalef32_pk_fp4_f32(w, t.x[2 * m][3] * inv, t.x[2 * m + 1][3] * inv, 1.0f, 3);
        o[m] = w; }
    unsigned char* dst = a.ws + (second ? WS_VQ : WS_UQ) + (size_t)e * TROW;
    *(v4u*)(dst + lane * 16) = o;
    *(unsigned short*)(dst + 1024 + lane * 2) = (unsigned short)sb;
}

namespace scan {
constexpr int TC = 16, NC = LTOK / TC;
static_assert(NC * TC == LTOK, "chunking");
constexpr int BUF_BYTES = 5 * TC * 64 * 4 + TC * 32 * 4;
constexpr int OFF_W = 0, OFF_A = TC * 256, OFF_B = 2 * TC * 256, OFF_KT = 3 * TC * 256, OFF_R = 4 * TC * 256, OFF_V = 5 * TC * 256;
constexpr int OFF_Y = 2 * BUF_BYTES, YB_BYTES = TC * 16 * 16 * 8;
typedef float f32x2v __attribute__((ext_vector_type(2)));
template <int CTRL> __device__ __forceinline__ float dpp_add(float x) { return x + __int_as_float(__builtin_amdgcn_update_dpp(0, __float_as_int(x), CTRL, 0xf, 0xf, false)); }
__device__ __forceinline__ float row16_sum(float x) { x = dpp_add<0x128>(x); x = dpp_add<0x124>(x); x = dpp_add<0x122>(x); x = dpp_add<0x121>(x); return x; }

struct PLoad { v2u r, k, om, ic; unsigned v; };
struct SOps { f32x4v w, a, b, t, r; f32x2v v; };

__device__ __forceinline__ void scan_item(const Args& a, const Ctx& C, int item) {
    unsigned char* ws = a.ws;
    const bf16* RKV = (const bf16*)(ws + WS_RKV); const bf16* OMIC = (const bf16*)(ws + WS_OMIC); bf16* Y = (bf16*)(ws + WS_Y);
    const int chain = item >> 1, half = item & 1, b = chain >> 5, h = (chain >> 1) & 15, dir = chain & 1;
    const bf16* OM = OMIC + (size_t)dir * TP * 1024; const bf16* IC = OMIC + (size_t)(2 + dir) * TP * 1024; bf16* Yd = Y + (size_t)dir * TP * 1024;
    LAS unsigned char* L = C.lds;
    const int tid = C.tid;
    const bool producer = tid >= 256;
    const int pt = tid & 255;
    const int ps = pt >> 4, pc = (pt & 15) * 4, pvr = (pt & 15) * 2;
    float kkc[4], kac[4];
#pragma unroll
    for (int e = 0; e < 4; ++e) { kkc[e] = a.in[I_KK][h * 64 + pc + e]; kac[e] = a.in[I_KA][h * 64 + pc + e]; }
    const int rp = pt >> 4, cg = pt & 15;
    f32x2v S0a = {0.f, 0.f}, S0b = {0.f, 0.f}, S1a = {0.f, 0.f}, S1b = {0.f, 0.f};
    int xrow = 1 << 30;
    float dtv[32]; DefItem dit; int dcur = 1 << 30; LAS float* dscr = (LAS float*)(L + OFF_Y + 2 * YB_BYTES) + ((tid >> 6) & 3) * (64 * 33);
    TabRow trow; int trw = 1 << 30; const int lane_ = tid & 63, trow0 = item * 4 + ((tid >> 6) & 3), tstride = 256 * 4;
    PLoad ldA, ldB;
#define tok_row(c, s) ((long)b * LTOK + (dir ? (LTOK - 1 - ((c) * TC + (s))) : ((c) * TC + (s))))
#define P_ISSUE(ld, c) do { if ((c) < NC) { const long m_ = tok_row((c), ps); const bf16* rk = RKV + m_ * 3072 + h * 64 + pc; \
        ld.r = *(const v2u*)rk; ld.k = *(const v2u*)(rk + 1024); ld.v = *(const unsigned*)(RKV + m_ * 3072 + 2048 + h * 64 + half * 32 + pvr); \
        ld.om = *(const v2u*)(OM + m_ * 1024 + h * 64 + pc); ld.ic = *(const v2u*)(IC + m_ * 1024 + h * 64 + pc); } } while (0)
#define P_STAGE(ld, c) do { if ((c) < NC) { LAS unsigned char* B_ = L + ((c) & 1) * BUF_BYTES; \
        const float r_[4] = {bf_lo(ld.r.x), bf_hi(ld.r.x), bf_lo(ld.r.y), bf_hi(ld.r.y)}; \
        const float k_[4] = {bf_lo(ld.k.x), bf_hi(ld.k.x), bf_lo(ld.k.y), bf_hi(ld.k.y)}; \
        const float o_[4] = {bf_lo(ld.om.x), bf_hi(ld.om.x), bf_lo(ld.om.y), bf_hi(ld.om.y)}; \
        const float i_[4] = {bf_lo(ld.ic.x), bf_hi(ld.ic.x), bf_lo(ld.ic.y), bf_hi(ld.ic.y)}; \
        float kk_[4]; float ss_ = 0.f; \
        _Pragma("unroll") for (int e = 0; e < 4; ++e) { kk_[e] = k_[e] * kkc[e]; ss_ += kk_[e] * kk_[e]; } \
        ss_ = row16_sum(ss_); \
        const float inv_ = 1.0f / fmaxf(sqrtf(ss_), 1e-12f); \
        float w_[4], a_[4], b_[4], t_[4]; \
        _Pragma("unroll") for (int e = 0; e < 4; ++e) { kk_[e] *= inv_; w_[e] = 1.0f - o_[e]; a_[e] = -kk_[e]; b_[e] = kk_[e] * i_[e]; t_[e] = k_[e] * (1.0f + (i_[e] - 1.0f) * kac[e]); } \
        const int o2_ = ps * 256 + pc * 4; \
        *(LAS f32x4v*)(B_ + OFF_W + o2_) = (f32x4v){w_[0], w_[1], w_[2], w_[3]}; \
        *(LAS f32x4v*)(B_ + OFF_A + o2_) = (f32x4v){a_[0], a_[1], a_[2], a_[3]}; \
        *(LAS f32x4v*)(B_ + OFF_B + o2_) = (f32x4v){b_[0], b_[1], b_[2], b_[3]}; \
        *(LAS f32x4v*)(B_ + OFF_KT + o2_) = (f32x4v){t_[0], t_[1], t_[2], t_[3]}; \
        *(LAS f32x4v*)(B_ + OFF_R + o2_) = (f32x4v){r_[0], r_[1], r_[2], r_[3]}; \
        *(LAS f32x2v*)(B_ + OFF_V + ps * 128 + pvr * 4) = (f32x2v){bf_lo(ld.v), bf_hi(ld.v)}; } } while (0)
#define P_YOUT(c) do { if ((c) >= 0) { const LAS unsigned char* YB_ = L + OFF_Y + ((c) & 1) * YB_BYTES + (ps * 16 + (pt & 15)) * 128; \
        f32x4v s_ = *(const LAS f32x4v*)YB_; \
        _Pragma("unroll") for (int q = 1; q < 8; ++q) s_ += *(const LAS f32x4v*)(YB_ + q * 16); \
        *(unsigned*)(Yd + tok_row((c), ps) * 1024 + h * 64 + half * 32 + pvr) = pk2(s_.x + s_.z, s_.y + s_.w); } } while (0)
#define S_LOAD(o, Bc, s) do { const int o4_ = (s) * 256 + cg * 16; \
        o.w = *(const volatile LAS f32x4v*)(Bc + OFF_W + o4_); o.a = *(const volatile LAS f32x4v*)(Bc + OFF_A + o4_); o.b = *(const volatile LAS f32x4v*)(Bc + OFF_B + o4_); \
        o.t = *(const volatile LAS f32x4v*)(Bc + OFF_KT + o4_); o.r = *(const volatile LAS f32x4v*)(Bc + OFF_R + o4_); o.v = *(const volatile LAS f32x2v*)(Bc + OFF_V + (s) * 128 + rp * 8); } while (0)
#define S_Y(o, YBc, s) do { const f32x2v r01 = {o.r.x, o.r.y}, r23 = {o.r.z, o.r.w}; \
        f32x2v y0 = S0a * r01; y0 = S0b * r23 + y0; f32x2v y1 = S1a * r01; y1 = S1b * r23 + y1; \
        *(LAS f32x2v*)(YBc + ((s) * 16 + rp) * 128 + cg * 8) = (f32x2v){y0.x + y0.y, y1.x + y1.y}; } while (0)
#define S_STEP(o, op, YBc, s) do { \
        const f32x2v a01 = {o.a.x, o.a.y}, a23 = {o.a.z, o.a.w}, w01 = {o.w.x, o.w.y}, w23 = {o.w.z, o.w.w}, b01 = {o.b.x, o.b.y}, b23 = {o.b.z, o.b.w}; \
        const f32x2v t01 = {o.t.x, o.t.y}, t23 = {o.t.z, o.t.w}; \
        f32x2v d0 = S0a * a01; d0 = S0b * a23 + d0; f32x2v d1 = S1a * a01; d1 = S1b * a23 + d1; \
        float sa0 = d0.x + d0.y, sa1 = d1.x + d1.y; \
        if ((s) > 0) S_Y(op, YBc, (s) - 1); \
        const f32x2v u0a = S0a * w01 + t01 * o.v.x, u0b = S0b * w23 + t23 * o.v.x, u1a = S1a * w01 + t01 * o.v.y, u1b = S1b * w23 + t23 * o.v.y; \
        sa0 = row16_sum(sa0); sa1 = row16_sum(sa1); \
        S0a = b01 * sa0 + u0a; S0b = b23 * sa0 + u0b; S1a = b01 * sa1 + u1a; S1b = b23 * sa1 + u1b; } while (0)

    if (producer) { P_ISSUE(ldA, 0); P_STAGE(ldA, 0); P_ISSUE(ldB, 1); P_ISSUE(ldA, 2); }
    __syncthreads();
#define CHUNK(c, LDN) do { \
        if (producer) { P_YOUT((c) - 1); P_STAGE(LDN, (c) + 1); P_ISSUE(LDN, (c) + 3); \
            if (((c) & 7) == 0) { trw = ((c) >> 3) * tstride + trow0; if (trw < 32768) tab_issue(a, trw, lane_, trow); } \
            else if (((c) & 7) == 4) { if (trw < 32768) tab_finish(a, trw, lane_, trow); } \
            if (((c) & 15) == 2) { dcur = ((c) >> 4) * tstride + trow0; if (dcur < NDEF) { def_decode(a, dcur, dit); def_issue(dit, lane_, dtv); } } \
            else if (((c) & 15) == 10) { if (dcur < NDEF) def_finish(dit, dscr, lane_, dtv); } \
            else if (((c) & 15) == 5) { xrow = ((c) >> 4) * tstride + trow0; if (xrow < NREAL) { const f32x4v* xs_ = (const f32x4v*)(a.in[I_X] + (size_t)xrow * DM) + lane_; \
                    _Pragma("unroll") for (int j_ = 0; j_ < 8; ++j_) trow.x[j_] = xs_[64 * j_]; } } \
            else if (((c) & 15) == 7) { if (xrow < NREAL) { v2u* xd_ = (v2u*)((unsigned char*)a.out + XB_OFF + (size_t)xrow * DM * 2) + lane_; \
                    _Pragma("unroll") for (int j_ = 0; j_ < 8; ++j_) xd_[64 * j_] = (v2u){pk2(trow.x[j_].x, trow.x[j_].y), pk2(trow.x[j_].z, trow.x[j_].w)}; } } } \
        else { const LAS unsigned char* Bc = L + ((c) & 1) * BUF_BYTES; LAS unsigned char* YBc = L + OFF_Y + ((c) & 1) * YB_BYTES; \
            SOps o0, o1, o2, o3; S_LOAD(o0, Bc, 0); S_LOAD(o1, Bc, 1); \
            _Pragma("unroll") for (int s = 0; s < TC; s += 4) { \
                S_LOAD(o2, Bc, s + 2); S_STEP(o0, o3, YBc, s); S_LOAD(o3, Bc, s + 3); S_STEP(o1, o0, YBc, s + 1); \
                if (s + 4 < TC) S_LOAD(o0, Bc, s + 4); S_STEP(o2, o1, YBc, s + 2); if (s + 5 < TC) S_LOAD(o1, Bc, s + 5); S_STEP(o3, o2, YBc, s + 3); } \
            S_Y(o3, YBc, TC - 1); } \
        __syncthreads(); } while (0)
#pragma unroll 1
    for (int c = 0; c + 1 < NC; c += 2) { CHUNK(c, ldB); CHUNK(c + 1, ldA); }
    CHUNK(NC - 1, ldB);
#undef CHUNK
    if (producer) { P_YOUT(NC - 1); }
    __syncthreads();
#undef tok_row
#undef P_ISSUE
#undef P_STAGE
#undef P_YOUT
#undef S_LOAD
#undef S_STEP
#undef S_Y
}
}

__device__ __forceinline__ void p6_rwkv_finalize(const Args& a, const Ctx& C) {
    unsigned char* ws = a.ws;
    const bf16* RKV = (const bf16*)(ws + WS_RKV); const bf16* OMIC = (const bf16*)(ws + WS_OMIC); const bf16* Y = (const bf16*)(ws + WS_Y); bf16* G = (bf16*)(ws + WS_G);
    const int c0 = C.lane * 16;
    float ka[16], rk[16], lg[16], lb[16];
#pragma unroll
    for (int e = 0; e < 16; ++e) { ka[e] = a.in[I_KA][c0 + e]; rk[e] = a.in[I_RK][c0 + e]; lg[e] = a.in[I_LNG][c0 + e]; lb[e] = a.in[I_LNB][c0 + e]; }
    for (int rr = C.gw; rr < NREAL; rr += C.NGW) {
        const int m = (rr / SEQ) * LTOK + NMETA + (rr % SEQ);
        bf16* gp = G + (size_t)rr * 1024 + c0;
        float y[16], r[16], k[16], v[16], icm[16], g[16];
#define LD16(dst, ptr) do { const v4u t0_ = *(const v4u*)(ptr), t1_ = *(const v4u*)((ptr) + 8); \
        dst[0] = bf_lo(t0_.x); dst[1] = bf_hi(t0_.x); dst[2] = bf_lo(t0_.y); dst[3] = bf_hi(t0_.y); dst[4] = bf_lo(t0_.z); dst[5] = bf_hi(t0_.z); dst[6] = bf_lo(t0_.w); dst[7] = bf_hi(t0_.w); \
        dst[8] = bf_lo(t1_.x); dst[9] = bf_hi(t1_.x); dst[10] = bf_lo(t1_.y); dst[11] = bf_hi(t1_.y); dst[12] = bf_lo(t1_.z); dst[13] = bf_hi(t1_.z); dst[14] = bf_lo(t1_.w); dst[15] = bf_hi(t1_.w); } while (0)
        { float yb[16]; LD16(y, Y + (size_t)m * 1024 + c0); LD16(yb, Y + (size_t)TP * 1024 + (size_t)m * 1024 + c0);
#pragma unroll
          for (int e = 0; e < 16; ++e) y[e] += yb[e]; }
        { float ib[16]; LD16(icm, OMIC + (size_t)2 * TP * 1024 + (size_t)m * 1024 + c0); LD16(ib, OMIC + (size_t)3 * TP * 1024 + (size_t)m * 1024 + c0);
#pragma unroll
          for (int e = 0; e < 16; ++e) icm[e] = 0.5f * (icm[e] + ib[e]); }
        LD16(r, RKV + (size_t)m * 3072 + c0); LD16(k, RKV + (size_t)m * 3072 + 1024 + c0); LD16(v, RKV + (size_t)m * 3072 + 2048 + c0); LD16(g, gp);
#undef LD16
        float s1 = 0.f, bn = 0.f;
#pragma unroll
        for (int e = 0; e < 16; ++e) { s1 += y[e]; bn += r[e] * (k[e] * (1.0f + (icm[e] - 1.0f) * ka[e])) * rk[e]; }
        s1 += __shfl_xor(s1, 1); s1 += __shfl_xor(s1, 2); bn += __shfl_xor(bn, 1); bn += __shfl_xor(bn, 2);
        const float mu = s1 * (1.0f / 64.0f); float s2 = 0.f;
#pragma unroll
        for (int e = 0; e < 16; ++e) { y[e] -= mu; s2 += y[e] * y[e]; }
        s2 += __shfl_xor(s2, 1); s2 += __shfl_xor(s2, 2);
        const float rstd = 1.0f / sqrtf(s2 * (1.0f / 64.0f) + 64e-5f);
        float o[16];
#pragma unroll
        for (int e = 0; e < 16; ++e) o[e] = (y[e] * rstd * lg[e] + lb[e] + bn * v[e]) * g[e];
        v4u w8;
        w8.x = pk4_f8(o[0] * F8S_Y, o[1] * F8S_Y, o[2] * F8S_Y, o[3] * F8S_Y); w8.y = pk4_f8(o[4] * F8S_Y, o[5] * F8S_Y, o[6] * F8S_Y, o[7] * F8S_Y);
        w8.z = pk4_f8(o[8] * F8S_Y, o[9] * F8S_Y, o[10] * F8S_Y, o[11] * F8S_Y); w8.w = pk4_f8(o[12] * F8S_Y, o[13] * F8S_Y, o[14] * F8S_Y, o[15] * F8S_Y);
        *(v4u*)(ws + WS_YR8 + (size_t)rr * 1024 + c0) = w8;
    }
}

constexpr int NEXP = 16384;
constexpr size_t WS_EXPG = 138 * MiB;

__device__ __forceinline__ void p9_norm_tables(const Args& a, const Ctx& C) {
    unsigned char* ws = a.ws;
    const bf16* H1 = (const bf16*)(ws + WS_H1); bf16* N2 = (bf16*)(ws + WS_N2);
    const float* g = a.in[I_NFG];
    constexpr int RB = 2;
    for (int m0 = C.gw; m0 < NREAL; m0 += RB * C.NGW) {
        v2u t[RB][8];
#pragma unroll
        for (int i = 0; i < RB; ++i) { const int m = m0 + i * C.NGW; if (m < NREAL) { const v2u* xr = (const v2u*)(H1 + (size_t)m * DM) + C.lane;
#pragma unroll
            for (int j = 0; j < 8; ++j) t[i][j] = xr[64 * j]; } }
#pragma unroll
        for (int i = 0; i < RB; ++i) { const int m = m0 + i * C.NGW; if (m < NREAL) {
            unsigned long long* o8 = (unsigned long long*)(N2 + (size_t)m * DM) + C.lane; const f32x4v* gr = (const f32x4v*)g + C.lane;
            f32x4v v[8]; float s = 0.f;
#pragma unroll
            for (int j = 0; j < 8; ++j) { v[j] = (f32x4v){bf_lo(t[i][j].x), bf_hi(t[i][j].x), bf_lo(t[i][j].y), bf_hi(t[i][j].y)}; s += (v[j].x * v[j].x + v[j].y * v[j].y) + (v[j].z * v[j].z + v[j].w * v[j].w); }
            const float rstd = 1.0f / sqrtf(wave_sum(s) * (1.f / DM) + NORM_EPS);
#pragma unroll
            for (int j = 0; j < 8; ++j) { const f32x4v gg = gr[64 * j];
                o8[64 * j] = (unsigned long long)pk2(v[j].x * rstd * gg.x, v[j].y * rstd * gg.y) | ((unsigned long long)pk2(v[j].z * rstd * gg.z, v[j].w * rstd * gg.w) << 32); } } }
    }
}

__device__ __forceinline__ unsigned fkey(float f) { const unsigned u = __float_as_uint(f); return (u & 0x80000000u) ? ~u : (u | 0x80000000u); }
__device__ __forceinline__ float fkey_inv(unsigned k) { const unsigned u = (k & 0x80000000u) ? (k ^ 0x80000000u) : ~k; return __uint_as_float(u); }

__device__ __forceinline__ void bitonic16_desc(unsigned (&c)[16]) {
#pragma unroll
    for (int j = 8; j > 0; j >>= 1)
#pragma unroll
        for (int i = 0; i < 16; ++i) { const int l = i ^ j; if (l > i) { const unsigned hi = c[i] > c[l] ? c[i] : c[l], lo = c[i] > c[l] ? c[l] : c[i]; c[i] = hi; c[l] = lo; } }
}
__device__ __forceinline__ void sort16_desc(unsigned (&c)[16]) {
#pragma unroll
    for (int k = 2; k <= 16; k <<= 1)
#pragma unroll
        for (int j = k >> 1; j > 0; j >>= 1)
#pragma unroll
            for (int i = 0; i < 16; ++i) { const int l = i ^ j;
                if (l > i) { const unsigned hi = c[i] > c[l] ? c[i] : c[l], lo = c[i] > c[l] ? c[l] : c[i]; const bool desc = ((i & k) == 0); c[i] = desc ? hi : lo; c[l] = desc ? lo : hi; } }
}
__device__ __forceinline__ float h2f_(unsigned short h) { return (float)__builtin_bit_cast(_Float16, h); }
__device__ __forceinline__ void p10b_select(const Args& a, const Ctx& C) {
    unsigned char* ws = a.ws;
    const unsigned short* SC = (const unsigned short*)(ws + WS_SC);
    unsigned long long* EXPG = (unsigned long long*)(ws + WS_EXPG);
    LAS unsigned* keys = (LAS unsigned*)C.lds;
    for (int blk = blockIdx.x; blk < NREAL / 32; blk += C.G) {
        {
            const unsigned short* sblk = SC + (size_t)blk * 32 * DM;
            LAS unsigned char* stg = C.lds + 512 * 16 * 4;
            unsigned v[16];
            v4u gl[8];
#define P10_FETCH(ln_) do { _Pragma("unroll") for (int j = 0; j < 8; ++j) { const int P = C.tid + 512 * j, L = P >> 3, cc = P & 7; \
                gl[j] = *(const v4u*)(sblk + (size_t)(L >> 4) * DM + (L & 15) * 128 + (ln_) * 64 + cc * 8); } } while (0)
            P10_FETCH(0);
#pragma unroll 1
            for (int ln = 0; ln < 2; ++ln) {
                __syncthreads();
#pragma unroll
                for (int j = 0; j < 8; ++j) { const int P = C.tid + 512 * j, L = P >> 3, cc = P & 7; *(LAS v4u*)(stg + L * 144 + cc * 16) = gl[j]; }
                __syncthreads();
                if (ln < 1) P10_FETCH(ln + 1);
                v4u xb[8];
#pragma unroll
                for (int q = 0; q < 8; ++q) xb[q] = *(const LAS v4u*)(stg + C.tid * 144 + q * 16);
#pragma unroll
                for (int hc = 0; hc < 4; ++hc) {
                    unsigned c[16];
#pragma unroll
                    for (int q = 0; q < 2; ++q)
#pragma unroll
                        for (int e = 0; e < 4; ++e) { const unsigned w = xb[2 * hc + q][e]; const int k0 = 64 * ln + 16 * hc + 8 * q + 2 * e;
                            c[8 * q + 2 * e] = (fkey(h2f_((unsigned short)(w & 0xffffu))) & ~0x7fu) | (unsigned)(127 - k0);
                            c[8 * q + 2 * e + 1] = (fkey(h2f_((unsigned short)(w >> 16))) & ~0x7fu) | (unsigned)(127 - (k0 + 1)); }
                    sort16_desc(c);
                    if (ln == 0 && hc == 0) {
#pragma unroll
                        for (int k = 0; k < 16; ++k) v[k] = c[k];
                    } else {
#pragma unroll
                        for (int k = 0; k < 16; ++k) v[k] = v[k] > c[15 - k] ? v[k] : c[15 - k];
                        bitonic16_desc(v);
                    }
                }
            }
#undef P10_FETCH
#pragma unroll
            for (int k = 0; k < 16; k += 4) *(LAS v4u*)(keys + C.tid * 16 + k) = (v4u){v[k], v[k + 1], v[k + 2], v[k + 3]};
        }
        __syncthreads();
        if (C.tid < 256) {
            const int tl = C.tid >> 3, hh = C.tid & 7, r = blk * 32 + tl;
            const LAS unsigned* ka = keys + (tl * 16 + 2 * hh) * 16; const LAS unsigned* kb = ka + 16;
            const float rs_ = ((const float*)(ws + WS_RSTD))[r];
            float af[16], bf_[16];
#pragma unroll
            for (int k = 0; k < 16; ++k) { af[k] = fkey_inv((ka[k] & ~0x7fu) | 0x40u) * rs_; bf_[k] = fkey_inv((kb[k] & ~0x7fu) | 0x40u) * rs_; }
            unsigned w[16];
#pragma unroll
            for (int k = 0; k < 16; ++k) w[k] = 0u;
#pragma unroll
            for (int i = 0; i < 16; ++i)
#pragma unroll
                for (int j = 0; j < 16; ++j)
                    if ((i + 1) * (j + 1) <= 16) {
                        unsigned x = (fkey(af[i] + bf_[j]) & ~0xffu) | (unsigned)(255 - (i * 16 + j));
#pragma unroll
                        for (int k = 0; k < 16; ++k) { const unsigned t = w[k] > x ? w[k] : x; x = w[k] > x ? x : w[k]; w[k] = t; }
                    }
            float sv[16]; const float mx = fkey_inv((w[0] & ~0xffu) | 0x80u); float z = 0.f;
#pragma unroll
            for (int k = 0; k < 16; ++k) { sv[k] = __expf(fkey_inv((w[k] & ~0xffu) | 0x80u) - mx); z += sv[k]; }
            const float rz = 1.0f / z;
            unsigned long long* out = EXPG + (size_t)r * 128 + hh * 16;
#pragma unroll
            for (int k = 0; k < 16; ++k) { const int c = 255 - (int)(w[k] & 0xffu); const int i1 = 127 - (int)(ka[c >> 4] & 0x7fu), i2 = 127 - (int)(kb[c & 15] & 0x7fu);
                out[k] = (unsigned long long)(unsigned)(i1 * 128 + i2) | ((unsigned long long)__float_as_uint(sv[k] * rz) << 32); }
        }
        __syncthreads();
    }
}

__device__ __forceinline__ float gelu_erf(float v) {
    const float av = fabsf(v), t = __builtin_amdgcn_rcpf(av * 0.2316418882f + 1.0f);
    float q = t * 0.5307027145f + (-0.7265760135f); q = q * t + 0.7107068705f; q = q * t + (-0.142248368f); q = q * t + 0.127414796f; q = q * t;
    const float e = __builtin_amdgcn_exp2f((v * v) * (-0.72134752044f));
    const float m = v * (q * e);
    return v < 0.f ? m : v - m;
}

typedef float f32x2w __attribute__((ext_vector_type(2)));
__device__ __forceinline__ float wave_total(float x) {
    x = scan::row16_sum(x);
    const int xi = __float_as_int(x);
    return (__int_as_float(__builtin_amdgcn_readlane(xi, 0)) + __int_as_float(__builtin_amdgcn_readlane(xi, 16))) + (__int_as_float(__builtin_amdgcn_readlane(xi, 32)) + __int_as_float(__builtin_amdgcn_readlane(xi, 48)));
}
typedef _Float16 h2t __attribute__((ext_vector_type(2)));
__device__ __forceinline__ void p11_peer_out(const Args& a, const Ctx& C) {
    unsigned char* ws = a.ws;
    const bf16* H1 = (const bf16*)(ws + WS_H1); const bf16* N2 = (const bf16*)(ws + WS_N2);
    const unsigned char* U = ws + WS_UQ; const unsigned char* V = ws + WS_VQ;
    const unsigned long long* EXPG = (const unsigned long long*)(ws + WS_EXPG);
    constexpr int PT = 4;
    LAS unsigned long long* egw = (LAS unsigned long long*)(C.lds) + C.wave * (PT * 128);
    LAS float* cw = (LAS float*)(C.lds + NWAVES * PT * 128 * 8) + C.wave * (PT * 128);
    const float* fg = a.in[I_FNG];
#define FP4H(w, b) __builtin_amdgcn_cvt_scalef32_pk_f16_fp4((w), 1.0f, (b))
#define PE_ISSUE(T, RR, SS, t_, q0) do { if (rbase + (t_) * C.NGW < NREAL) { _Pragma("unroll") for (int x_ = 0; x_ < 8; ++x_) { \
            const unsigned e_ = (unsigned)__builtin_amdgcn_readfirstlane((int)(unsigned)egw[(t_) * 128 + (q0) + x_]); const unsigned char* p_ = (T) + (size_t)e_ * TROW; \
            RR[x_] = *(const v4u*)(p_ + C.lane * 16); SS[x_] = *(const unsigned short*)(p_ + 1024 + C.lane * 2); } } } while (0)
#define PE_SW32(x, y) ({ auto r_ = __builtin_amdgcn_permlane32_swap(__float_as_uint(x), __float_as_uint(y), false, false); __uint_as_float(r_[0]) + __uint_as_float(r_[1]); })
#define PE_SW16(x, y) ({ auto r_ = __builtin_amdgcn_permlane16_swap(__float_as_uint(x), __float_as_uint(y), false, false); __uint_as_float(r_[0]) + __uint_as_float(r_[1]); })
    const int pe_row = C.lane >> 4, pe_idx = (pe_row >> 1) + 2 * (pe_row & 1) + 4 * ((C.lane >> 3) & 1);
    for (int rbase = C.gw; rbase < NREAL; rbase += PT * C.NGW) {
        h2t st[PT][16];
#pragma unroll
        for (int t = 0; t < PT; ++t) { const int r = rbase + t * C.NGW; if (r < NREAL) {
            LAS unsigned long long* eg = egw + t * 128;
            const unsigned long long pa = EXPG[(size_t)r * 128 + C.lane], pb = EXPG[(size_t)r * 128 + 64 + C.lane];
            const unsigned ba = ((unsigned)pa >> 10) & 15u, bbk = ((unsigned)pb >> 10) & 15u;
            unsigned base = 0u, posa = 0u, posb = 0u;
#pragma unroll
            for (unsigned q = 0; q < 16; ++q) { const unsigned long long ma = __ballot(ba == q), mb = __ballot(bbk == q);
                const unsigned ca = __builtin_amdgcn_mbcnt_hi((unsigned)(ma >> 32), __builtin_amdgcn_mbcnt_lo((unsigned)ma, 0u)), cb = __builtin_amdgcn_mbcnt_hi((unsigned)(mb >> 32), __builtin_amdgcn_mbcnt_lo((unsigned)mb, 0u));
                const unsigned na = (unsigned)__popcll(ma);
                if (ba == q) posa = base + ca; if (bbk == q) posb = base + na + cb;
                base += na + (unsigned)__popcll(mb); }
            eg[posa] = pa; eg[posb] = pb;
            const float rs = ((const float*)(ws + WS_RSTD))[r];
#pragma unroll
            for (int m = 0; m < 4; ++m) { const v2u t0 = *(const v2u*)(N2 + (size_t)r * DM + 512 * m + C.lane * 4), t1 = *(const v2u*)(N2 + (size_t)r * DM + 512 * m + 256 + C.lane * 4);
                st[t][4 * m + 0] = __builtin_bit_cast(h2t, __builtin_amdgcn_cvt_pkrtz(bf_lo(t0.x) * rs, bf_lo(t1.x) * rs)); st[t][4 * m + 1] = __builtin_bit_cast(h2t, __builtin_amdgcn_cvt_pkrtz(bf_hi(t0.x) * rs, bf_hi(t1.x) * rs));
                st[t][4 * m + 2] = __builtin_bit_cast(h2t, __builtin_amdgcn_cvt_pkrtz(bf_lo(t0.y) * rs, bf_lo(t1.y) * rs)); st[t][4 * m + 3] = __builtin_bit_cast(h2t, __builtin_amdgcn_cvt_pkrtz(bf_hi(t0.y) * rs, bf_hi(t1.y) * rs)); } } }
        LDS_WAIT();
        v4u ra[8], rbv[8]; unsigned short sa[8], sb[8];
#define PE_UROUND(t_, RR, SS, q0) do { if (rbase + (t_) * C.NGW < NREAL) { float zs[8]; _Pragma("unroll") for (int x_ = 0; x_ < 8; ++x_) { float d0_ = 0.f, d1_ = 0.f; \
                _Pragma("unroll") for (int m = 0; m < 4; m += 2) { \
                    d0_ = __builtin_amdgcn_fdot2(FP4H(RR[x_][m], 0), st[t_][4 * m + 0], d0_, false); d1_ = __builtin_amdgcn_fdot2(FP4H(RR[x_][m + 1], 0), st[t_][4 * (m + 1) + 0], d1_, false); \
                    d0_ = __builtin_amdgcn_fdot2(FP4H(RR[x_][m], 1), st[t_][4 * m + 1], d0_, false); d1_ = __builtin_amdgcn_fdot2(FP4H(RR[x_][m + 1], 1), st[t_][4 * (m + 1) + 1], d1_, false); \
                    d0_ = __builtin_amdgcn_fdot2(FP4H(RR[x_][m], 2), st[t_][4 * m + 2], d0_, false); d1_ = __builtin_amdgcn_fdot2(FP4H(RR[x_][m + 1], 2), st[t_][4 * (m + 1) + 2], d1_, false); \
                    d0_ = __builtin_amdgcn_fdot2(FP4H(RR[x_][m], 3), st[t_][4 * m + 3], d0_, false); d1_ = __builtin_amdgcn_fdot2(FP4H(RR[x_][m + 1], 3), st[t_][4 * (m + 1) + 3], d1_, false); } \
                zs[x_] = (d0_ + d1_) * bf2f(SS[x_]); } \
            const float t0_ = scan::row16_sum(PE_SW16(PE_SW32(zs[0], zs[1]), PE_SW32(zs[2], zs[3]))); \
            const float t1_ = scan::row16_sum(PE_SW16(PE_SW32(zs[4], zs[5]), PE_SW32(zs[6], zs[7]))); \
            const float cv_ = gelu_erf((C.lane & 8) ? t1_ : t0_) * __uint_as_float(((const LAS unsigned*)(egw + (t_) * 128))[2 * ((q0) + pe_idx) + 1]); \
            if ((C.lane & 7) == 0) cw[(t_) * 128 + (q0) + pe_idx] = cv_; } } while (0)
        PE_ISSUE(U, ra, sa, 0, 0); PE_ISSUE(U, rbv, sb, 1, 0);
#pragma unroll 1
        for (int q = 0; q < 128; q += 8) {
#pragma unroll
            for (int t = 0; t < PT; t += 2) {
                PE_UROUND(t, ra, sa, q);     if (t + 2 < PT) PE_ISSUE(U, ra, sa, t + 2, q);  else if (q + 8 < 128) PE_ISSUE(U, ra, sa, 0, q + 8);
                PE_UROUND(t + 1, rbv, sb, q); if (t + 3 < PT) PE_ISSUE(U, rbv, sb, t + 3, q); else if (q + 8 < 128) PE_ISSUE(U, rbv, sb, 1, q + 8);
            }
        }
#undef PE_UROUND
        LDS_WAIT();
#pragma unroll
        for (int t = 0; t < PT; ++t)
#pragma unroll
            for (int p = 0; p < 16; ++p) st[t][p] = (h2t){(_Float16)0.f, (_Float16)0.f};
#define PE_VROUND(t_, RR, SS, q0) do { if (rbase + (t_) * C.NGW < NREAL) { const f32x4v ca_ = *(const LAS f32x4v*)(cw + (t_) * 128 + (q0)), cb_ = *(const LAS f32x4v*)(cw + (t_) * 128 + (q0) + 4); \
            _Pragma("unroll") for (int x_ = 0; x_ < 8; ++x_) { const float c_ = (x_ < 4 ? ca_[x_ & 3] : cb_[x_ & 3]) * bf2f(SS[x_]); const h2t ch_ = __builtin_bit_cast(h2t, __builtin_amdgcn_cvt_pkrtz(c_, c_)); \
                _Pragma("unroll") for (int m = 0; m < 4; ++m) { st[t_][4 * m + 0] = FP4H(RR[x_][m], 0) * ch_ + st[t_][4 * m + 0]; st[t_][4 * m + 1] = FP4H(RR[x_][m], 1) * ch_ + st[t_][4 * m + 1]; \
                    st[t_][4 * m + 2] = FP4H(RR[x_][m], 2) * ch_ + st[t_][4 * m + 2]; st[t_][4 * m + 3] = FP4H(RR[x_][m], 3) * ch_ + st[t_][4 * m + 3]; } } } } while (0)
        PE_ISSUE(V, ra, sa, 0, 0); PE_ISSUE(V, rbv, sb, 1, 0);
#pragma unroll 1
        for (int q = 0; q < 128; q += 8) {
#pragma unroll
            for (int t = 0; t < PT; t += 2) {
                PE_VROUND(t, ra, sa, q);     if (t + 2 < PT) PE_ISSUE(V, ra, sa, t + 2, q);  else if (q + 8 < 128) PE_ISSUE(V, ra, sa, 0, q + 8);
                PE_VROUND(t + 1, rbv, sb, q); if (t + 3 < PT) PE_ISSUE(V, rbv, sb, t + 3, q); else if (q + 8 < 128) PE_ISSUE(V, rbv, sb, 1, q + 8);
            }
        }
#undef PE_VROUND
#pragma unroll
        for (int t = 0; t < PT; ++t) { const int r = rbase + t * C.NGW; if (r < NREAL) {
            f32x2w acc[4][4]; float s = 0.f;
#pragma unroll
            for (int m = 0; m < 4; ++m) { const v2u t0 = *(const v2u*)(N2 + (size_t)r * DM + 512 * m + C.lane * 4), t1 = *(const v2u*)(N2 + (size_t)r * DM + 512 * m + 256 + C.lane * 4);
                const f32x4v q0 = *(const f32x4v*)(a.in[I_NFG] + 512 * m + C.lane * 4), q1 = *(const f32x4v*)(a.in[I_NFG] + 512 * m + 256 + C.lane * 4);
#define RC_(v) __builtin_amdgcn_rcpf(v)
                const f32x4v x0 = {bf_lo(t0.x) * RC_(q0.x), bf_hi(t0.x) * RC_(q0.y), bf_lo(t0.y) * RC_(q0.z), bf_hi(t0.y) * RC_(q0.w)}, x1 = {bf_lo(t1.x) * RC_(q1.x), bf_hi(t1.x) * RC_(q1.y), bf_lo(t1.y) * RC_(q1.z), bf_hi(t1.y) * RC_(q1.w)};
#undef RC_
#pragma unroll
                for (int i = 0; i < 4; ++i) { acc[m][i].x = (float)st[t][4 * m + i][0] + x0[i]; acc[m][i].y = (float)st[t][4 * m + i][1] + x1[i]; s += acc[m][i].x * acc[m][i].x + acc[m][i].y * acc[m][i].y; } }
            const float rstd = 1.0f / sqrtf(wave_sum(s) * (1.f / DM) + NORM_EPS);
#pragma unroll
            for (int m = 0; m < 4; ++m) { const int e0 = 512 * m + C.lane * 4; const f32x4v g0 = *(const f32x4v*)(fg + e0), g1 = *(const f32x4v*)(fg + e0 + 256);
                *(f32x4v*)(a.out + (size_t)r * DM + e0) = (f32x4v){acc[m][0].x * rstd * g0.x, acc[m][1].x * rstd * g0.y, acc[m][2].x * rstd * g0.z, acc[m][3].x * rstd * g0.w};
                *(f32x4v*)(a.out + (size_t)r * DM + e0 + 256) = (f32x4v){acc[m][0].y * rstd * g1.x, acc[m][1].y * rstd * g1.y, acc[m][2].y * rstd * g1.z, acc[m][3].y * rstd * g1.w}; } } }
        LDS_WAIT();
    }
#undef PE_ISSUE
#undef PE_SW32
#undef PE_SW16
#undef FP4H
}
#define XB_TMO      128
#define XB_XCNT(j)  (256  + 64 * (j))
#define XB_XSUB(j)  (1280 + 64 * (j))
#define XB_XGEN(j)  (2304 + 64 * (j))
#define XB_TOP      3328
#define XB_TOPGEN   3392
#define XCD_BAR_WORDS 3456
#define XB_SPIN_CAP (1u << 23)

__device__ __forceinline__ unsigned xb_ld(unsigned* p)              { return __hip_atomic_load(p, __ATOMIC_RELAXED, __HIP_MEMORY_SCOPE_AGENT); }
__device__ __forceinline__ unsigned xb_add(unsigned* p, unsigned v) { return __hip_atomic_fetch_add(p, v, __ATOMIC_RELAXED, __HIP_MEMORY_SCOPE_AGENT); }
__device__ __forceinline__ unsigned xb_xcc_id() { return (unsigned)__builtin_amdgcn_s_getreg((3 << 11) | 20) & 0xFu; }
#define XB_SPIN(cond, bar) do { unsigned _sp = 0; while (cond) { __builtin_amdgcn_s_sleep(1); \
    if ((++_sp & 255u) == 0u) { if (xb_ld(&(bar)[XB_TMO])) break; if (_sp > XB_SPIN_CAP) { atomicAdd(&(bar)[XB_TMO], 1u); break; } } } } while (0)

struct XcdBarrier {
    unsigned* bar; unsigned x;
    volatile LAS unsigned* st;
};

__device__ __forceinline__ XcdBarrier xcd_barrier_post(unsigned* bar, volatile LAS unsigned* st) {
    XcdBarrier b; b.bar = bar; b.x = xb_xcc_id(); b.st = st;
    if (threadIdx.x == 0) (void)xb_add(&bar[XB_XCNT(b.x)], 1u);
    return b;
}
__device__ __forceinline__ void xcd_barrier_complete(unsigned* bar, unsigned x, unsigned& nloc, unsigned& nx) {
    const unsigned G = gridDim.x * gridDim.y * gridDim.z;
    unsigned sum, cnt, mine, sp = 0u;
    for (;;) {
        sum = 0u; cnt = 0u; mine = 0u;
#pragma unroll
        for (unsigned j = 0; j < 16; ++j) { const unsigned c = xb_ld(&bar[XB_XCNT(j)]); sum += c; cnt += (c > 0u) ? 1u : 0u; mine = (j == x) ? c : mine; }
        if (sum == G) break;
        __builtin_amdgcn_s_sleep(1);
        if ((++sp & 255u) == 0u) { if (xb_ld(&bar[XB_TMO])) break; if (sp > XB_SPIN_CAP) { atomicAdd(&bar[XB_TMO], 1u); break; } }
    }
    nloc = mine > 0u ? mine : 1u; nx = cnt > 0u ? cnt : 1u;
}

__device__ __forceinline__ void xcd_barrier(const XcdBarrier& b) {
    asm volatile("s_waitcnt vmcnt(0)" ::: "memory");
    __syncthreads();
    if (threadIdx.x == 0) {
        unsigned* bar = b.bar;
        __builtin_amdgcn_s_waitcnt(0);
        unsigned nloc = b.st[0], nx = b.st[1];
        if (nloc == 0u) { xcd_barrier_complete(bar, b.x, nloc, nx); b.st[0] = nloc; b.st[1] = nx; }
        const unsigned old = xb_add(&bar[XB_XSUB(b.x)], 1u);
        const unsigned gen = old / nloc;
        if (old + 1u == (gen + 1u) * nloc) {
            __builtin_amdgcn_fence(__ATOMIC_RELEASE, "agent");
            asm volatile("s_waitcnt vmcnt(0)" ::: "memory");
            const unsigned og = xb_add(&bar[XB_TOP], 1u);
            const unsigned tg = og / nx;
            if (og + 1u == (tg + 1u) * nx) xb_add(&bar[XB_TOPGEN], 1u);
            else XB_SPIN(xb_ld(&bar[XB_TOPGEN]) == tg, bar);
            __builtin_amdgcn_fence(__ATOMIC_ACQUIRE, "agent");
            xb_add(&bar[XB_XGEN(b.x)], 1u);
            asm volatile("s_waitcnt vmcnt(0)" ::: "memory");
        } else {
            XB_SPIN(xb_ld(&bar[XB_XGEN(b.x)]) == gen, bar);
            __builtin_amdgcn_fence(__ATOMIC_ACQUIRE, "agent");
            asm volatile("s_waitcnt vmcnt(0)" ::: "memory");
        }
    }
    __syncthreads();
}

constexpr int LDS_BYTES = 147456;
template <class F> __device__ __forceinline__ void run_gemm(LAS unsigned char* lds, const bf16* A, const bf16* Bt, int M, int N, int K, int G, const F& f) {
    pg8::Gemm g{A, Bt, M, N, K}; pg8::StaticOrder S; S.init(M, N, G, (int)blockIdx.x);
    epi::EpiG<F> E{f};
    pg8::gemm_phase<epi::EpiG<F>, pg8::StaticOrder, true, true>(lds, g, S, E);
}

template <class F> __device__ __forceinline__ void run_gemm8(LAS unsigned char* lds, const void* A8, const void* Bt8, int M, int N, int K, int G, const F& f) {
    pg8::Gemm g{(const bf16*)A8, (const bf16*)Bt8, M, N, K / 2}; pg8::StaticOrder S; S.init(M, N, G, (int)blockIdx.x);
    epi::EpiG<F> E{f};
    pg8::gemm_phase<epi::EpiG<F>, pg8::StaticOrder, true, true, true>(lds, g, S, E);
}

__global__ void __launch_bounds__(NWAVES * 64, 2) mega_fwd(Args a) {
    extern __shared__ __attribute__((aligned(16))) unsigned char lds_raw[];
    cg::grid_group grid = cg::this_grid();
    Ctx C;
    C.lds = (LAS unsigned char*)lds_raw;
    C.tid = threadIdx.x; C.lane = C.tid & 63; C.wave = __builtin_amdgcn_readfirstlane(C.tid >> 6);
    C.G = gridDim.x; { const int bx = blockIdx.x; C.vcu = (C.G % 8 == 0) ? (bx % 8) * (C.G / 8) + bx / 8 : bx; }
    C.gw = blockIdx.x * NWAVES + C.wave; C.NGW = C.G * NWAVES;
    unsigned char* ws = a.ws;
    volatile LAS unsigned* MISC = (volatile LAS unsigned*)(C.lds + LDS_BYTES - 64);
    if (C.tid < 16) MISC[C.tid] = 0u;
    __syncthreads();
    XcdBarrier xbar = xcd_barrier_post((unsigned*)(ws + WS_CTL), MISC);
#define REFRESH() do { int t_ = threadIdx.x; asm volatile("" : "+v"(t_)); C.tid = t_; C.lane = t_ & 63; } while (0)
#define GSYNC() do { xcd_barrier(xbar); REFRESH(); } while (0)

    p0_prologue(a, C);
    grid.sync(); REFRESH();
    run_gemm(C.lds, (const bf16*)(ws + WS_XN), (const bf16*)(ws + WS_WIN), TP, NPROJ_A, DM, C.G, epi::FStoreBf16{(bf16*)(ws + WS_PROJ) + 1024, NPROJ});
    { const int extra = ((TP / 256) * (NPROJ_A / 256)) % C.G, skip = (2 * extra < C.G) ? extra : 0;
      pg8::Gemm g{(const bf16*)(ws + WS_XN8T), (const bf16*)(ws + WS_WIN8), TP, NPROJ_B, DM / 2}; pg8::StaticOrder S; S.init(TP, NPROJ_B, C.G - skip, (int)blockIdx.x - skip);
      epi::EpiG<epi::FStoreProjB> E{epi::FStoreProjB{(bf16*)(ws + WS_PROJ), NPROJ, 1.0f / (F8S_XN * F8S_W)}};
      pg8::gemm_phase<epi::EpiG<epi::FStoreProjB>, pg8::StaticOrder, true, true, true>(C.lds, g, S, E); }
    { pg8::Gemm g{(const bf16*)(ws + WS_AFULL), (const bf16*)(ws + WS_WQBF), DM, DM, 256, DM, 256}; pg8::StaticOrder S; S.init(DM, DM, C.G, (int)blockIdx.x);
      epi::EpiG<epi::FStoreBf16> E{epi::FStoreBf16{(bf16*)(ws + WS_WSCORE), DM}};
      pg8::gemm_phase<epi::EpiG<epi::FStoreBf16>, pg8::StaticOrder, true, true>(C.lds, g, S, E); }
    GSYNC();
    p2_mla_prep(a, C);
    p2_rwkv_prep(a, C);
    GSYNC();
    run_gemm(C.lds, (const bf16*)(ws + WS_AW), (const bf16*)(ws + WS_WLW), TP, 4096, 256, C.G, epi::FLoraW{(bf16*)(ws + WS_OMIC), a.in[I_W0], a.in[I_A0]});
    run_gemm(C.lds, (const bf16*)(ws + WS_AG), (const bf16*)(ws + WS_WLG), NREAL, 1024, 256, C.G, epi::FStoreBf16{(bf16*)(ws + WS_G), 1024});
    GSYNC();
    for (int it = blockIdx.x; it < 256; it += C.G) scan::scan_item(a, C, it);
    GSYNC();
    p6_rwkv_finalize(a, C);
    GSYNC();
    {
        const long gt = (long)C.gw * 64 + C.lane, NGT = (long)C.NGW * 64;
        for (long i = gt; i < (long)BATCH * MLA_H * 128 * 14; i += NGT) { const int bhd = (int)(i / 14), u = (int)(i - (long)bhd * 14), bh = bhd >> 7, d = bhd & 127;
            const int tile = u < 6 ? 64 : 65, unit = u < 6 ? (u < 3 ? u + 1 : u + 2) : u - 6;
            *(v2u*)(ws + WS_V + ((size_t)(bh * NTV + tile) * 128 + d) * 64 + unit * 8) = (v2u){0u, 0u}; }
    }
    run_gemm8(C.lds, ws + WS_QN, ws + WS_WUQ, NREAL, NQ, 512, C.G,
              epi::FQRope{ws + WS_Q, (const float*)(ws + WS_ROPE), (const float*)(ws + WS_ROPE + MiB)});
    run_gemm8(C.lds, ws + WS_KVN, ws + WS_WUKV, TP, NKV, 512, C.G, epi::FKVSplit{ws + WS_KV, ws + WS_V});
    GSYNC();
    {
        constexpr int NQB = SEQ / 256, NUNITS = BATCH * MLA_H * NQB;
        for (int u = C.vcu; u < NUNITS; u += C.G) {
            const int bh = u / NQB, qb = u - bh * NQB;
            att::attn_unit(bh / MLA_H, bh % MLA_H, qb * 256, ws + WS_Q, ws + WS_KV, ws + WS_V, ws + WS_KR, (bf16*)(ws + WS_O), (char*)lds_raw);
        }
    }
    GSYNC();
    run_gemm8(C.lds, a.out, ws + WS_WG, NREAL, DM, DM, C.G, epi::FGate8{ws + WS_BUF2, a.in[I_BGATE]});
    run_gemm8(C.lds, ws + WS_YR8, ws + WS_WPR, NREAL, DM, 1024, C.G, epi::FMulG8<0>{(bf16*)(ws + WS_BUF1), ws + WS_BUF2, nullptr, nullptr});
    run_gemm8(C.lds, a.out, ws + WS_WG + (size_t)DM * DM, NREAL, DM, DM, C.G, epi::FGate8{ws + WS_BUF2, a.in[I_BGATE] + DM});
    run_gemm8(C.lds, ws + WS_O, ws + WS_WPM, NREAL, DM, DM, C.G, epi::FMulG8<1>{nullptr, ws + WS_BUF2, (const bf16*)(ws + WS_BUF1), ws + WS_M8});
    GSYNC();
    { pg8::Gemm g{(const bf16*)(ws + WS_M8), (const bf16*)(ws + WS_WO), NREAL, DM, DM / 2}; pg8::StaticOrder S; S.init(NREAL, DM, C.G, (int)blockIdx.x);
      epi::EpiResidNorm E{(bf16*)(ws + WS_N2), (const bf16*)((const unsigned char*)a.out + XB_OFF), a.in[I_NFG], (float*)(ws + WS_SSQ), 1.0f / (F8S_M * F8S_W)};
      pg8::gemm_phase<epi::EpiResidNorm, pg8::StaticOrder, true, true, true>(C.lds, g, S, E); }
    GSYNC();
    { const float* SSQ = (const float*)(ws + WS_SSQ); float* RSTD = (float*)(ws + WS_RSTD);
      for (int r = C.gw * 64 + C.lane; r < NREAL; r += C.NGW * 64) { float s = 0.f;
#pragma unroll
          for (int j = 0; j < 8; ++j) { const f32x4v t = *(const f32x4v*)(SSQ + (size_t)r * 32 + 4 * j); s += (t.x + t.y) + (t.z + t.w); }
          RSTD[r] = 1.0f / sqrtf(s * (1.f / DM) + NORM_EPS); } }
    run_gemm(C.lds, (const bf16*)(ws + WS_N2), (const bf16*)(ws + WS_WSCORE), NREAL, DM, DM, C.G, epi::FStoreF16{(unsigned short*)(ws + WS_SC), DM});
    GSYNC();
    p10b_select(a, C);
    GSYNC();
    p11_peer_out(a, C);
}

extern "C" void kernel_launch(void* const* d_in, const int* in_sizes, int n_in, void* d_out, int out_size, void* d_ws, size_t ws_size, hipStream_t stream) {
    static int grid = 0;
    if (grid == 0) {
        int dev = 0, cus = 0, per_cu = 0;
        if (n_in != 29 || ws_size < WS_END) { fprintf(stderr, "kernel_launch: unexpected n_in %d / ws_size %zu (need %zu)\n", n_in, ws_size, (size_t)WS_END); grid = -1; return; }
        if (hipGetDevice(&dev) != hipSuccess || hipDeviceGetAttribute(&cus, hipDeviceAttributeMultiprocessorCount, dev) != hipSuccess) { grid = -1; return; }
        if (hipFuncSetAttribute((const void*)mega_fwd, hipFuncAttributeMaxDynamicSharedMemorySize, LDS_BYTES) != hipSuccess) { fprintf(stderr, "kernel_launch: hipFuncSetAttribute failed\n"); grid = -1; return; }
        if (hipOccupancyMaxActiveBlocksPerMultiprocessor(&per_cu, (const void*)mega_fwd, NWAVES * 64, LDS_BYTES) != hipSuccess || per_cu < 1) { fprintf(stderr, "kernel_launch: occupancy query says %d\n", per_cu); grid = -1; return; }
        grid = cus;
    }
    if (grid < 0) return;
    if (hipMemsetAsync((char*)d_ws + WS_CTL, 0, 16384, stream) != hipSuccess) { fprintf(stderr, "kernel_launch: memset of barrier words failed\n"); return; }
    Args a{};
    for (int i = 0; i < 29; ++i) a.in[i] = (const float*)d_in[i];
    a.out = (float*)d_out; a.ws = (unsigned char*)d_ws;
    void* args[] = {&a};
    hipError_t e = hipLaunchCooperativeKernel((const void*)mega_fwd, dim3(grid), dim3(NWAVES * 64), args, LDS_BYTES, stream);
    if (e != hipSuccess) fprintf(stderr, "cooperative launch failed: %s (grid %d)\n", hipGetErrorString(e), grid);
}
```

```cpp
#include <hip/hip_runtime.h>
#include <hip/hip_cooperative_groups.h>
#include <cstdio>
#include <cstdint>
namespace cg = cooperative_groups;

constexpr int NWAVES = 8;
constexpr int BATCH = 4, SEQ = 4096, DM = 2048, NMETA = 16, LTOK = SEQ + NMETA;
constexpr int TOK = BATCH * LTOK;
constexpr int TP = 16640;
constexpr int RW_DIM = 1024, RW_H = 16, RW_N = 64;
constexpr int NPROJ = 4608;
constexpr int C_QD = 3584, C_KVD = 4096, C_KR = 3488, NPROJ_A = 1024, NPROJ_B = NPROJ - NPROJ_A;
constexpr int MLA_H = 16, QK_NOPE = 128, QK_ROPE = 64, QK_D = 192, V_D = 128;
constexpr int NQ = MLA_H * QK_D;
constexpr int NKV = MLA_H * (QK_NOPE + V_D);
constexpr float NORM_EPS = 1e-6f;
constexpr float QSCALE = 0.07216878364870322f * 1.4426950408889634f;

constexpr size_t MiB = 1u << 20;
constexpr size_t WS_WSCORE = 0;
constexpr size_t WS_WIN    = 8 * MiB;
constexpr size_t WS_WIN8   = 12 * MiB;
constexpr size_t WS_XN8T   = 166 * MiB;
constexpr size_t WS_WG     = 27 * MiB;
constexpr size_t WS_WUQ    = 43 * MiB;
constexpr size_t WS_WUKV   = 46 * MiB;
constexpr size_t WS_WPR    = 50 * MiB;
constexpr size_t WS_WPM    = 54 * MiB;
constexpr size_t WS_WO     = 62 * MiB;
constexpr size_t WS_WLG    = 70 * MiB;
constexpr size_t WS_WLW    = 71 * MiB;
constexpr size_t WS_AFULL  = 75 * MiB;
constexpr size_t WS_WQBF   = 83 * MiB;
constexpr size_t WS_XN     = 96 * MiB;
constexpr size_t SZ_T512   = (size_t)TP * 512 * 2;
constexpr int NREAL = BATCH * SEQ;
constexpr size_t WS_YR8    = 96 * MiB;
constexpr size_t WS_AW     = 96 * MiB;
constexpr size_t WS_AG     = 105 * MiB;
constexpr size_t WS_QN     = 113 * MiB;
constexpr size_t WS_KVN    = 130 * MiB;
constexpr size_t WS_KR     = 147 * MiB;
constexpr size_t SZ_T1024  = (size_t)TP * 1024 * 2;
constexpr size_t WS_RKV    = 166 * MiB;
constexpr size_t WS_PROJ   = 263 * MiB + 512 * 1024;
constexpr size_t WS_OMIC   = 263 * MiB + 512 * 1024;
constexpr size_t WS_G      = 393 * MiB + 512 * 1024;
constexpr size_t WS_Y      = 426 * MiB;
constexpr size_t WS_Q      = 166 * MiB;
constexpr size_t WS_KV     = 263 * MiB + 512 * 1024;
constexpr size_t WS_V      = 298 * MiB;
constexpr size_t WS_O      = 426 * MiB;
constexpr size_t WS_M8     = 458 * MiB;
constexpr size_t WS_BUF1   = 166 * MiB;
constexpr size_t WS_BUF2   = 231 * MiB;
constexpr size_t WS_H1     = 296 * MiB;
constexpr size_t WS_N2     = 166 * MiB;
constexpr size_t WS_SSQ    = 154 * MiB;
constexpr size_t WS_RSTD   = 156 * MiB;
constexpr int TROW = 1152;
constexpr size_t WS_UQ     = 8 * MiB;
constexpr size_t WS_VQ     = 75 * MiB;
constexpr size_t WS_SC     = 360 * MiB;
constexpr size_t WS_ROPE   = 492 * MiB;
constexpr size_t WS_CTL    = 495 * MiB;
constexpr size_t XB_OFF    = 32 * MiB;
constexpr size_t WS_END    = 496 * MiB;
static_assert(WS_KR + (size_t)TP * 64 * 2 <= 166 * MiB, "XNR region");
static_assert(WS_PROJ + (size_t)TP * NPROJ * 2 <= 418 * MiB + 512 * 1024, "proj");

#define GAS __attribute__((address_space(1)))
#define LAS __attribute__((address_space(3)))
typedef unsigned short bf16;
typedef unsigned v4u __attribute__((ext_vector_type(4)));
typedef unsigned v2u __attribute__((ext_vector_type(2)));
typedef float f32x4v __attribute__((ext_vector_type(4)));
#define LDS_WAIT() asm volatile("s_waitcnt lgkmcnt(0)" ::: "memory")
#define VM_WAIT() asm volatile("s_waitcnt vmcnt(0)" ::: "memory")
__device__ __forceinline__ unsigned pk2(float lo, float hi) { unsigned r; asm volatile("v_cvt_pk_bf16_f32 %0, %1, %2" : "=v"(r) : "v"(lo), "v"(hi)); return r; }
__device__ __forceinline__ float bf_lo(unsigned w) { return __uint_as_float(w << 16); }
__device__ __forceinline__ float bf_hi(unsigned w) { return __uint_as_float(w & 0xffff0000u); }
__device__ __forceinline__ float bf2f(bf16 h) { return __uint_as_float((unsigned)h << 16); }
__device__ __forceinline__ float wave_sum(float v) {
#pragma unroll
    for (int o = 1; o < 64; o <<= 1) v += __shfl_xor(v, o);
    return v;
}
__device__ __forceinline__ float f8c(float x) { return __builtin_amdgcn_fmed3f(x, -448.f, 448.f); }
__device__ __forceinline__ unsigned pk4_f8(float a, float b, float c, float d) { const int w = __builtin_amdgcn_cvt_pk_fp8_f32(f8c(a), f8c(b), 0, false); return (unsigned)__builtin_amdgcn_cvt_pk_fp8_f32(f8c(c), f8c(d), w, true); }
constexpr float F8S_W = 256.f, F8S_XN = 8.f, F8S_O = 128.f, F8S_M = 16.f, F8S_Y = 8.f, F8S_Q = 64.f, F8S_K = 8.f, F8S_V = 8.f;
constexpr int NTV = 66;
__device__ __forceinline__ float sigmoidf_(float x) { return 1.0f / (1.0f + __expf(-x)); }
__device__ __forceinline__ float sigmoid_rcp_(float x) { return __builtin_amdgcn_rcpf(1.0f + __expf(-x)); }

struct Args { const float* in[29]; float* out; unsigned char* ws; };
enum { I_X = 0, I_META, I_NMG, I_WIN, I_BGATE, I_SHIFT, I_WUP, I_W0, I_AUP, I_A0, I_GUP, I_KK, I_KA, I_RK, I_LNG, I_LNB, I_QNG, I_WUQ, I_KVNG, I_WUKV,
       I_PRW, I_PMLA, I_WO, I_NFG, I_PWQ, I_PKEYS, I_PU, I_PV, I_FNG };
namespace pg8 {
#define PG8_LAS __attribute__((address_space(3)))
typedef unsigned short bf16_t;
typedef short bf16x8 __attribute__((ext_vector_type(8)));
typedef float f32x4 __attribute__((ext_vector_type(4)));
typedef unsigned u32x4 __attribute__((ext_vector_type(4)));
constexpr int BM = 256, BK = 64, HALF = 128, HTB = HALF * BK * 2  , STAGE_BYTES = 8 * HTB, NXCD = 8, WGM = 8;

__host__ __device__ __forceinline__ int lds_byte(int r, int c) { const int st = (r >> 4) * 2 + (c >> 5), rr = r & 15, cc = c & 31, ob = rr * 64 + cc * 2; return st * 1024 + (ob ^ (((ob >> 9) & 1) << 5)); }
__host__ __device__ __forceinline__ void stage_rc(int b, int& R, int& C) { const int st = b / 1024, sb = b % 1024, swz = sb ^ (((sb >> 9) & 1) << 5); R = (st >> 1) * 16 + swz / 64; C = (st & 1) * 32 + (swz % 64) / 2; }
__host__ __device__ __forceinline__ int perm32(int rho) { const int n = rho >> 4, i = rho & 15; return 8 * (i >> 2) + 4 * n + (i & 3); }

struct Unit { int pm, pn; };
struct Gemm { const bf16_t* A; const bf16_t* Bt; int M, N, K; int ld = 0, kwin = 0; };

struct StaticOrder {
    int nM, nN, nwg, G, c;
    __host__ __device__ void init(int M, int N, int G_, int c_) { nM = M / BM; nN = N / BM; nwg = nM * nN; G = G_; c = c_; }
    __host__ __device__ bool next(int i, Unit& u) const {
        const long L = (long)i * G + c; if (c < 0 || L >= nwg) return false;
        int wgid = (int)L; { const int q = nwg / NXCD, r = nwg % NXCD, xcd = wgid % NXCD, off = wgid / NXCD; wgid = (xcd < r ? xcd * (q + 1) : r * (q + 1) + (xcd - r) * q) + off; }
        const int nig = WGM * nN, gid = wgid / nig, fm = gid * WGM, gsz = (nM - fm) < WGM ? (nM - fm) : WGM;
        u.pm = fm + ((wgid % nig) % gsz); u.pn = (wgid % nig) / gsz; return true;
    }
    __device__ __forceinline__ void a_ready(const Unit&) const {}
    __device__ __forceinline__ void done(const Unit&) const {}
};

__device__ __forceinline__ unsigned cvt_pk_bf16(float lo, float hi) { unsigned r; asm volatile("v_cvt_pk_bf16_f32 %0, %1, %2" : "=v"(r) : "v"(lo), "v"(hi)); return r; }
typedef float f32x2 __attribute__((ext_vector_type(2)));
typedef int i32x8 __attribute__((ext_vector_type(8)));
typedef int i32x4 __attribute__((ext_vector_type(4)));
__device__ __forceinline__ void mfma_f8(f32x4& acc, const i32x8 a, const i32x8 b) { asm volatile("v_mfma_f32_16x16x128_f8f6f4 %0, %1, %2, %0" : "+v"(acc) : "v"(a), "v"(b)); }
__device__ __forceinline__ i32x8 cat8(bf16x8 lo, bf16x8 hi) { const i32x4 a = __builtin_bit_cast(i32x4, lo), b = __builtin_bit_cast(i32x4, hi); return (i32x8){a[0], a[1], a[2], a[3], b[0], b[1], b[2], b[3]}; }

template <class Epi, class Sched, bool ALIGN_EPI = false, bool SP2 = false, bool FP8 = false>
__device__ __forceinline__ void gemm_phase(PG8_LAS unsigned char* lds, const Gemm g, const Sched& S, const Epi& E) {
    int tid_ = threadIdx.x; asm volatile("" : "+v"(tid_));
    const int tid = tid_, wid = __builtin_amdgcn_readfirstlane(tid >> 6), lane = tid & 63, wr = wid >> 2, wc = wid & 3, fr = lane & 15, fq = lane >> 4;
    int nt_ = g.K / BK; if constexpr (FP8) asm volatile("" : "+s"(nt_));
    const int K = g.K, nt = nt_, ld = g.ld ? g.ld : g.K; const size_t kwb = (size_t)g.kwin * 2;
    unsigned voffA[2], voffB[2];
#pragma unroll
    for (int i = 0; i < 2; ++i) { int R, C; stage_rc(tid * 16 + i * 8192, R, C); const int Rb = Epi::PERM ? ((R & ~31) + perm32(R & 31)) : R;
        voffA[i] = (unsigned)(R * ld + C) * 2u; voffB[i] = (unsigned)(Rb * ld + C) * 2u; }
    const size_t kstep = (size_t)(BK * 2);
    const size_t hstep = (size_t)HALF * ld * 2;
    const size_t tstep = 2 * hstep;
    const unsigned ldsw = (unsigned)wid * 1024u;
    const int aoff = lds_byte(wr * 64 + fr, fq * 8), boff = lds_byte(wc * 32 + fr, fq * 8);
#define PG8_SA(b, h) (((b) * 2 + (h)) * HTB)
#define PG8_SB(b, h) ((4 + (b) * 2 + (h)) * HTB)
#define PG8_STAGE(bufoff, gbase, voff) do { _Pragma("unroll") for (int _i = 0; _i < 2; ++_i) \
        __builtin_amdgcn_global_load_lds((const unsigned*)((const char*)(gbase) + (voff)[_i]), (PG8_LAS unsigned*)(lds + (bufoff) + ldsw + _i * 8192), 16, 0, 0); } while (0)
#define PG8_LDA(dst, b, h) do { _Pragma("unroll") for (int m = 0; m < 4; ++m) _Pragma("unroll") for (int k = 0; k < 2; ++k) dst[m][k] = *(const PG8_LAS bf16x8*)(lds + PG8_SA(b, h) + aoff + m * 2048 + k * 1024); } while (0)
#define PG8_LDB(dst, b, h) do { _Pragma("unroll") for (int n = 0; n < 2; ++n) _Pragma("unroll") for (int k = 0; k < 2; ++k) dst[n][k] = *(const PG8_LAS bf16x8*)(lds + PG8_SB(b, h) + boff + n * 2048 + k * 1024); } while (0)
#define PG8_MMA(ai, bj, At, Bt) do { __builtin_amdgcn_s_setprio(1); _Pragma("unroll") for (int m = 0; m < 4; ++m) _Pragma("unroll") for (int n = 0; n < 2; ++n) { \
        if constexpr (FP8) mfma_f8(acc[ai][bj][m][n], cat8(Bt[n][0], Bt[n][1]), cat8(At[m][0], At[m][1])); \
        else { _Pragma("unroll") for (int k = 0; k < 2; ++k) acc[ai][bj][m][n] = __builtin_amdgcn_mfma_f32_16x16x32_bf16(Bt[n][k], At[m][k], acc[ai][bj][m][n], 0, 0, 0); } } \
        __builtin_amdgcn_s_setprio(0); } while (0)
#define PG8_WAIT_V(n) asm volatile("s_waitcnt vmcnt(" #n ")" ::: "memory")
#define PG8_WAIT_L(n) asm volatile("s_waitcnt lgkmcnt(" #n ")" ::: "memory")
#define PG8_BAR __builtin_amdgcn_s_barrier()
#define PG8_SCHED __builtin_amdgcn_sched_barrier(0)
    Unit cur, nxt; int ui = 0;
    if (!S.next(0, cur)) return;
    f32x4 acc[2][2][4][2];
#pragma unroll
    for (int a = 0; a < 2; ++a)
#pragma unroll
        for (int b = 0; b < 2; ++b)
#pragma unroll
            for (int m = 0; m < 4; ++m)
#pragma unroll
                for (int n = 0; n < 2; ++n) acc[a][b][m][n] = (f32x4){0.f, 0.f, 0.f, 0.f};
    bf16x8 At[4][2], B0[2][2], B1[2][2];
    const char* cA = (const char*)g.A + (size_t)cur.pm * tstep + (size_t)cur.pm * kwb; const char* cB = (const char*)g.Bt + (size_t)cur.pn * tstep + (size_t)cur.pm * kwb;
    S.a_ready(cur);
    if constexpr (SP2) {
        PG8_STAGE(PG8_SB(0, 0), cB, voffB); PG8_STAGE(PG8_SB(0, 1), cB + hstep, voffB); PG8_STAGE(PG8_SA(0, 0), cA, voffA); PG8_STAGE(PG8_SA(0, 1), cA + hstep, voffA);
        if (wr == 1) PG8_BAR;
        PG8_WAIT_V(2); PG8_BAR;
        PG8_STAGE(PG8_SB(1, 0), cB + kstep, voffB); PG8_STAGE(PG8_SA(1, 0), cA + kstep, voffA); PG8_STAGE(PG8_SB(1, 1), cB + hstep + kstep, voffB);
        PG8_WAIT_V(6); PG8_BAR;
    } else {
        PG8_STAGE(PG8_SB(0, 0), cB, voffB); PG8_STAGE(PG8_SA(0, 0), cA, voffA); PG8_STAGE(PG8_SB(0, 1), cB + hstep, voffB); PG8_STAGE(PG8_SA(0, 1), cA + hstep, voffA);
        if (wr == 1) PG8_BAR;
        PG8_WAIT_V(4); PG8_BAR;
        PG8_STAGE(PG8_SB(1, 0), cB + kstep, voffB); PG8_STAGE(PG8_SA(1, 0), cA + kstep, voffA); PG8_STAGE(PG8_SB(1, 1), cB + hstep + kstep, voffB);
        PG8_WAIT_V(6); PG8_BAR;
    }
    for (;;) {
        const bool has_next = S.next(ui + 1, nxt);
        const char* nA = has_next ? (const char*)g.A + (size_t)nxt.pm * tstep + (size_t)nxt.pm * kwb : cA; const char* nB = has_next ? (const char*)g.Bt + (size_t)nxt.pn * tstep + (size_t)nxt.pm * kwb : cB;
        for (int t = 0; t < nt; t += 2) {
            const bool last = (t == nt - 2);
            const char* a1 = cA + (size_t)(t + 1) * kstep;
            const char* a2 = last ? nA : cA + (size_t)(t + 2) * kstep; const char* b2 = last ? nB : cB + (size_t)(t + 2) * kstep;
            const char* a3 = a2 + kstep; const char* b3 = b2 + kstep;
            if (last && has_next) S.a_ready(nxt);
            if constexpr (SP2) {
            PG8_LDB(B0, 0, 0); PG8_LDB(B1, 0, 1); PG8_SCHED; PG8_LDA(At, 0, 0); PG8_STAGE(PG8_SA(1, 1), a1 + hstep, voffA);
            PG8_WAIT_V(8); PG8_WAIT_L(0); PG8_BAR; PG8_MMA(0, 0, At, B0); PG8_MMA(0, 1, At, B1); PG8_BAR; PG8_SCHED;
            PG8_LDA(At, 0, 1); PG8_STAGE(PG8_SB(0, 0), b2, voffB); PG8_STAGE(PG8_SB(0, 1), b2 + hstep, voffB); PG8_STAGE(PG8_SA(0, 0), a2, voffA);
            PG8_WAIT_V(8); PG8_WAIT_L(0); PG8_BAR; PG8_MMA(1, 0, At, B0); PG8_MMA(1, 1, At, B1); PG8_BAR; PG8_SCHED;
            PG8_LDB(B0, 1, 0); PG8_LDB(B1, 1, 1); PG8_SCHED; PG8_LDA(At, 1, 0); PG8_STAGE(PG8_SA(0, 1), a2 + hstep, voffA);
            PG8_WAIT_V(8); PG8_WAIT_L(0); PG8_BAR; PG8_MMA(0, 0, At, B0); PG8_MMA(0, 1, At, B1); PG8_BAR; PG8_SCHED;
            PG8_LDA(At, 1, 1); PG8_STAGE(PG8_SB(1, 0), b3, voffB); PG8_STAGE(PG8_SB(1, 1), b3 + hstep, voffB); PG8_STAGE(PG8_SA(1, 0), a3, voffA);
            PG8_WAIT_V(8); PG8_WAIT_L(0); PG8_BAR; PG8_MMA(1, 0, At, B0); PG8_MMA(1, 1, At, B1); PG8_BAR; PG8_SCHED;
            } else {
            PG8_LDB(B0, 0, 0); PG8_SCHED; PG8_LDA(At, 0, 0); PG8_STAGE(PG8_SA(1, 1), a1 + hstep, voffA);
            PG8_WAIT_L(8); PG8_BAR; PG8_WAIT_L(0); PG8_MMA(0, 0, At, B0); PG8_BAR; PG8_SCHED;
            PG8_LDB(B1, 0, 1); PG8_STAGE(PG8_SB(0, 0), b2, voffB);
            PG8_BAR; PG8_WAIT_L(0); PG8_MMA(0, 1, At, B1); PG8_BAR;
            PG8_LDA(At, 0, 1); PG8_STAGE(PG8_SA(0, 0), a2, voffA);
            PG8_BAR; PG8_WAIT_L(0); PG8_MMA(1, 0, At, B0); PG8_BAR; PG8_SCHED;
            PG8_STAGE(PG8_SB(0, 1), b2 + hstep, voffB);
            PG8_WAIT_V(6); PG8_BAR; PG8_MMA(1, 1, At, B1); PG8_BAR;
            PG8_LDB(B0, 1, 0); PG8_SCHED; PG8_LDA(At, 1, 0); PG8_STAGE(PG8_SA(0, 1), a2 + hstep, voffA);
            PG8_WAIT_L(8); PG8_BAR; PG8_WAIT_L(0); PG8_MMA(0, 0, At, B0); PG8_BAR; PG8_SCHED;
            PG8_LDB(B1, 1, 1); PG8_STAGE(PG8_SB(1, 0), b3, voffB);
            PG8_BAR; PG8_WAIT_L(0); PG8_MMA(0, 1, At, B1); PG8_BAR;
            PG8_LDA(At, 1, 1); PG8_STAGE(PG8_SA(1, 0), a3, voffA);
            PG8_BAR; PG8_WAIT_L(0); PG8_MMA(1, 0, At, B0); PG8_BAR; PG8_SCHED;
            PG8_STAGE(PG8_SB(1, 1), b3 + hstep, voffB);
            PG8_WAIT_V(6); PG8_BAR; PG8_MMA(1, 1, At, B1); PG8_BAR;
            }
        }
        if constexpr (FP8) asm volatile("s_nop 15\n\ts_nop 15" : "+v"(acc[1][1][0][0]), "+v"(acc[1][1][0][1]), "+v"(acc[1][1][1][0]), "+v"(acc[1][1][1][1]), "+v"(acc[1][1][2][0]), "+v"(acc[1][1][2][1]), "+v"(acc[1][1][3][0]), "+v"(acc[1][1][3][1]));
        if constexpr (ALIGN_EPI) { if (wr == 0) PG8_BAR; }
        if constexpr (!Epi::AFTER_DRAIN) { E(acc, cur, wr, wc, fr, fq); S.done(cur); }
        if (!has_next) break;
#pragma unroll
        for (int a = 0; a < 2; ++a)
#pragma unroll
            for (int b = 0; b < 2; ++b)
#pragma unroll
                for (int m = 0; m < 4; ++m)
#pragma unroll
                    for (int n = 0; n < 2; ++n) acc[a][b][m][n] = (f32x4){0.f, 0.f, 0.f, 0.f};
        cur = nxt; cA = nA; cB = nB; ++ui;
        if constexpr (ALIGN_EPI) { if (wr == 1) PG8_BAR; }
    }
    PG8_WAIT_V(0);
    if constexpr (!ALIGN_EPI) { if (wr == 0) PG8_BAR; }
    PG8_BAR;
    if constexpr (Epi::AFTER_DRAIN) { E.fused(acc, cur, wr, wc, fr, fq, lds, wid, lane); S.done(cur); }
#undef PG8_SA
#undef PG8_SB
#undef PG8_STAGE
#undef PG8_LDA
#undef PG8_LDB
#undef PG8_MMA
#undef PG8_WAIT_V
#undef PG8_WAIT_L
#undef PG8_BAR
#undef PG8_SCHED
}
}

namespace epi {
using pg8::f32x4; using pg8::Unit;
template <class F> struct EpiG {
    static constexpr bool PERM = true, AFTER_DRAIN = false;
    F f;
    __device__ __forceinline__ void operator()(const f32x4 (&acc)[2][2][4][2], const Unit& u, int wr, int wc, int fr, int fq) const {
        const int row0 = u.pm * 256 + wr * 64 + fr, col0 = u.pn * 256 + wc * 32 + 8 * fq;
#pragma unroll
        for (int ai = 0; ai < 2; ++ai)
#pragma unroll
            for (int m = 0; m < 4; ++m)
#pragma unroll
                for (int bj = 0; bj < 2; ++bj) f.tile8(row0 + ai * 128 + m * 16, col0 + bj * 128, acc[ai][bj][m][0], acc[ai][bj][m][1]);
    }
};
__device__ __forceinline__ v4u pack8(f32x4 a, f32x4 b) { v4u w; w.x = pk2(a[0], a[1]); w.y = pk2(a[2], a[3]); w.z = pk2(b[0], b[1]); w.w = pk2(b[2], b[3]); return w; }

struct FStoreBf16 { bf16* O; int ldc;
    __device__ __forceinline__ void tile8(int row, int col, f32x4 a, f32x4 b) const { *(v4u*)(O + (size_t)row * ldc + col) = pack8(a, b); } };

struct FStoreBf16S { bf16* O; int ldc; float sc;
    __device__ __forceinline__ void tile8(int row, int col, f32x4 a, f32x4 b) const { *(v4u*)(O + (size_t)row * ldc + col) = pack8(a * sc, b * sc); } };

struct FKVSplit { unsigned char* K8; unsigned char* VT;
    __device__ __forceinline__ void tile8(int row, int col, f32x4 a, f32x4 b) const {
        const int hh = col >> 8, c = col & 255; constexpr float sc = 1.0f / (F8S_XN * F8S_W), sk = sc * F8S_K, sv = sc * F8S_V;
        if (c < 128) { v2u o8; o8.x = pk4_f8(a[0] * sk, a[1] * sk, a[2] * sk, a[3] * sk); o8.y = pk4_f8(b[0] * sk, b[1] * sk, b[2] * sk, b[3] * sk); *(v2u*)(K8 + (size_t)row * (MLA_H * QK_NOPE) + hh * QK_NOPE + c) = o8; }
        else if (row < TOK) {
            const int bb = row / LTOK, l = row - bb * LTOK, tile = l >> 6, kk = l & 63, k5 = kk & 31;
            const int slot = ((k5 >> 2) & 1) * 32 + (kk >> 5) * 16 + (k5 & 3) + 4 * (k5 >> 3);
            unsigned char* p = VT + ((size_t)((bb * MLA_H + hh) * NTV + tile) * 128 + (c - 128)) * 64 + slot;
            const unsigned w0 = pk4_f8(a[0] * sv, a[1] * sv, a[2] * sv, a[3] * sv), w1 = pk4_f8(b[0] * sv, b[1] * sv, b[2] * sv, b[3] * sv);
            p[0] = (unsigned char)w0; p[64] = (unsigned char)(w0 >> 8); p[128] = (unsigned char)(w0 >> 16); p[192] = (unsigned char)(w0 >> 24);
            p[256] = (unsigned char)w1; p[320] = (unsigned char)(w1 >> 8); p[384] = (unsigned char)(w1 >> 16); p[448] = (unsigned char)(w1 >> 24);
        }
    } };

struct FStoreProjB { bf16* O; int ldc; float sc;
    __device__ __forceinline__ void tile8(int row, int col, f32x4 a, f32x4 b) const { *(v4u*)(O + (size_t)row * ldc + col + (col >= 1024 ? 1024 : 0)) = pack8(a * sc, b * sc); } };

struct FStoreF16 { unsigned short* O; int ldc;
    __device__ __forceinline__ void tile8(int row, int col, f32x4 a, f32x4 b) const {
        v4u w; w.x = __builtin_bit_cast(unsigned, __builtin_amdgcn_cvt_pkrtz(a[0], a[1])); w.y = __builtin_bit_cast(unsigned, __builtin_amdgcn_cvt_pkrtz(a[2], a[3]));
        w.z = __builtin_bit_cast(unsigned, __builtin_amdgcn_cvt_pkrtz(b[0], b[1])); w.w = __builtin_bit_cast(unsigned, __builtin_amdgcn_cvt_pkrtz(b[2], b[3]));
        *(v4u*)(O + (size_t)row * ldc + col) = w; } };

struct FStoreF32 { float* O; int ldc;
    __device__ __forceinline__ void tile8(int row, int col, f32x4 a, f32x4 b) const { float* p = O + (size_t)row * ldc + col; *(f32x4*)p = a; *(f32x4*)(p + 4) = b; } };

struct FQRope { unsigned char* Q; const float* cosT; const float* sinT;
    __device__ __forceinline__ void tile8(int row, int col, f32x4 a, f32x4 b) const {
        const int j = col % QK_D;
        if (j >= QK_NOPE) {
            const int l = NMETA + (row % SEQ), i0 = (j - QK_NOPE) >> 1;
            const f32x4 c = *(const f32x4*)(cosT + l * 32 + i0), s = *(const f32x4*)(sinT + l * 32 + i0);
            f32x4 ra, rb;
            ra[0] = a[0] * c[0] - a[1] * s[0]; ra[1] = a[0] * s[0] + a[1] * c[0];
            ra[2] = a[2] * c[1] - a[3] * s[1]; ra[3] = a[2] * s[1] + a[3] * c[1];
            rb[0] = b[0] * c[2] - b[1] * s[2]; rb[1] = b[0] * s[2] + b[1] * c[2];
            rb[2] = b[2] * c[3] - b[3] * s[3]; rb[3] = b[2] * s[3] + b[3] * c[3];
            a = ra; b = rb;
        }
        constexpr float QS = QSCALE * F8S_Q / (F8S_XN * F8S_W);
        v2u o8; o8.x = pk4_f8(a[0] * QS, a[1] * QS, a[2] * QS, a[3] * QS); o8.y = pk4_f8(b[0] * QS, b[1] * QS, b[2] * QS, b[3] * QS);
        *(v2u*)(Q + (size_t)row * NQ + col) = o8;
    } };

struct FLoraW { bf16* OMIC; const float* w0; const float* a0;
    __device__ __forceinline__ void tile8(int row, int col, f32x4 a, f32x4 b) const {
        const int seg = col >> 10, c = col & 1023;
        float v[8] = {a[0], a[1], a[2], a[3], b[0], b[1], b[2], b[3]};
        if (seg < 2) {
            const float* w = w0 + seg * 1024 + c;
#pragma unroll
            for (int i = 0; i < 8; ++i) { const float e = 0.6065306597126334f * sigmoid_rcp_(w[i] + v[i]); v[i] = 1.0f - __expf(-e); }
        } else {
            const float* w = a0 + (seg - 2) * 1024 + c;
#pragma unroll
            for (int i = 0; i < 8; ++i) v[i] = sigmoidf_(w[i] + v[i]);
        }
        v4u o; o.x = pk2(v[0], v[1]); o.y = pk2(v[2], v[3]); o.z = pk2(v[4], v[5]); o.w = pk2(v[6], v[7]);
        *(v4u*)(OMIC + (size_t)seg * TP * 1024 + (size_t)row * 1024 + c) = o;
    } };

struct FGateMul { bf16* BUF; const bf16* ADD; const float* bias; unsigned char* M8;
    __device__ __forceinline__ void tile8(int row, int col, f32x4 a, f32x4 b) const {
        const size_t off = (size_t)row * DM + col; constexpr float sc = 1.0f / (F8S_XN * F8S_W); a = a * sc; b = b * sc;
        const v4u t = *(const v4u*)(BUF + off);
        const f32x4 b0 = *(const f32x4*)(bias + col), b1 = *(const f32x4*)(bias + col + 4);
        float r[8];
        r[0] = sigmoidf_(a[0] + b0[0]) * bf_lo(t.x); r[1] = sigmoidf_(a[1] + b0[1]) * bf_hi(t.x);
        r[2] = sigmoidf_(a[2] + b0[2]) * bf_lo(t.y); r[3] = sigmoidf_(a[3] + b0[3]) * bf_hi(t.y);
        r[4] = sigmoidf_(b[0] + b1[0]) * bf_lo(t.z); r[5] = sigmoidf_(b[1] + b1[1]) * bf_hi(t.z);
        r[6] = sigmoidf_(b[2] + b1[2]) * bf_lo(t.w); r[7] = sigmoidf_(b[3] + b1[3]) * bf_hi(t.w);
        if (ADD) { const v4u m = *(const v4u*)(ADD + off);
            r[0] += bf_lo(m.x); r[1] += bf_hi(m.x); r[2] += bf_lo(m.y); r[3] += bf_hi(m.y); r[4] += bf_lo(m.z); r[5] += bf_hi(m.z); r[6] += bf_lo(m.w); r[7] += bf_hi(m.w); }
        if (M8) { v2u o8; o8.x = pk4_f8(r[0] * F8S_M, r[1] * F8S_M, r[2] * F8S_M, r[3] * F8S_M); o8.y = pk4_f8(r[4] * F8S_M, r[5] * F8S_M, r[6] * F8S_M, r[7] * F8S_M); *(v2u*)(M8 + off) = o8; return; }
        v4u o; o.x = pk2(r[0], r[1]); o.y = pk2(r[2], r[3]); o.z = pk2(r[4], r[5]); o.w = pk2(r[6], r[7]);
        *(v4u*)(BUF + off) = o;
    } };

struct FGate8 { unsigned char* G8; const float* bias;
    __device__ __forceinline__ void tile8(int row, int col, f32x4 a, f32x4 b) const {
        const size_t off = (size_t)row * DM + col; constexpr float sc = 1.0f / (F8S_XN * F8S_W);
        const f32x4 b0 = *(const f32x4*)(bias + col), b1 = *(const f32x4*)(bias + col + 4);
        unsigned q[8];
#pragma unroll
        for (int i = 0; i < 4; ++i) { q[i] = (unsigned)(255.0f * sigmoid_rcp_(a[i] * sc + b0[i]) + 0.5f); q[4 + i] = (unsigned)(255.0f * sigmoid_rcp_(b[i] * sc + b1[i]) + 0.5f); }
        v2u o; o.x = q[0] | (q[1] << 8) | (q[2] << 16) | (q[3] << 24); o.y = q[4] | (q[5] << 8) | (q[6] << 16) | (q[7] << 24);
        *(v2u*)(G8 + off) = o;
    } };
template <int PASS> struct FMulG8 { bf16* OUT; const unsigned char* G8; const bf16* ADD; unsigned char* M8;
    __device__ __forceinline__ void tile8(int row, int col, f32x4 a, f32x4 b) const {
        const size_t off = (size_t)row * DM + col; constexpr float sc = (1.0f / 255.0f) / ((PASS == 0 ? F8S_Y : F8S_O) * F8S_W);
        const v2u gv = *(const v2u*)(G8 + off);
        float r[8];
        r[0] = (float)(gv.x & 0xffu) * (a[0] * sc); r[1] = (float)((gv.x >> 8) & 0xffu) * (a[1] * sc); r[2] = (float)((gv.x >> 16) & 0xffu) * (a[2] * sc); r[3] = (float)(gv.x >> 24) * (a[3] * sc);
        r[4] = (float)(gv.y & 0xffu) * (b[0] * sc); r[5] = (float)((gv.y >> 8) & 0xffu) * (b[1] * sc); r[6] = (float)((gv.y >> 16) & 0xffu) * (b[2] * sc); r[7] = (float)(gv.y >> 24) * (b[3] * sc);
        if (ADD) { const v4u m = *(const v4u*)(ADD + off);
            r[0] += bf_lo(m.x); r[1] += bf_hi(m.x); r[2] += bf_lo(m.y); r[3] += bf_hi(m.y); r[4] += bf_lo(m.z); r[5] += bf_hi(m.z); r[6] += bf_lo(m.w); r[7] += bf_hi(m.w); }
        if (M8) { v2u o8; o8.x = pk4_f8(r[0] * F8S_M, r[1] * F8S_M, r[2] * F8S_M, r[3] * F8S_M); o8.y = pk4_f8(r[4] * F8S_M, r[5] * F8S_M, r[6] * F8S_M, r[7] * F8S_M); *(v2u*)(M8 + off) = o8; return; }
        v4u o; o.x = pk2(r[0], r[1]); o.y = pk2(r[2], r[3]); o.z = pk2(r[4], r[5]); o.w = pk2(r[6], r[7]);
        *(v4u*)(OUT + off) = o;
    } };

struct FResid { bf16* H1; const float* x; float sc;
    __device__ __forceinline__ void tile8(int row, int col, f32x4 a, f32x4 b) const {
        const size_t off = (size_t)row * DM + col; a = a * sc; b = b * sc;
        *(v4u*)(H1 + off) = pack8(*(const f32x4*)(x + off) + a, *(const f32x4*)(x + off + 4) + b);
    } };
struct EpiResidNorm {
    static constexpr bool PERM = true, AFTER_DRAIN = false;
    bf16* N2; const bf16* xb; const float* g; float* SSQ; float sc;
    __device__ __forceinline__ void operator()(const f32x4 (&acc)[2][2][4][2], const Unit& u, int wr, int wc, int fr, int fq) const {
        const int row0 = u.pm * 256 + wr * 64 + fr, col0 = u.pn * 256 + wc * 32 + 8 * fq;
#pragma unroll
        for (int ai = 0; ai < 2; ++ai)
#pragma unroll
            for (int m = 0; m < 4; ++m) { const int row = row0 + ai * 128 + m * 16; float ss = 0.f;
#pragma unroll
                for (int bj = 0; bj < 2; ++bj) { const int col = col0 + bj * 128; const size_t off = (size_t)row * DM + col;
                    const v4u xv = *(const v4u*)(xb + off);
                    const f32x4 a = (f32x4){bf_lo(xv.x), bf_hi(xv.x), bf_lo(xv.y), bf_hi(xv.y)} + acc[ai][bj][m][0] * sc, b = (f32x4){bf_lo(xv.z), bf_hi(xv.z), bf_lo(xv.w), bf_hi(xv.w)} + acc[ai][bj][m][1] * sc;
                    const f32x4 g0 = *(const f32x4*)(g + col), g1 = *(const f32x4*)(g + col + 4);
                    *(v4u*)(N2 + off) = pack8(a * g0, b * g1);
                    ss += (a[0] * a[0] + a[1] * a[1]) + (a[2] * a[2] + a[3] * a[3]) + (b[0] * b[0] + b[1] * b[1]) + (b[2] * b[2] + b[3] * b[3]); }
                { auto r_ = __builtin_amdgcn_permlane32_swap(__float_as_uint(ss), __float_as_uint(ss), false, false); ss = __uint_as_float(r_[0]) + __uint_as_float(r_[1]); }
                { auto r_ = __builtin_amdgcn_permlane16_swap(__float_as_uint(ss), __float_as_uint(ss), false, false); ss = __uint_as_float(r_[0]) + __uint_as_float(r_[1]); }
                if (fq == 0) SSQ[(size_t)row * 32 + u.pn * 4 + wc] = ss; }
    }
};
}

namespace att {
using bf16x8 = __attribute__((ext_vector_type(8))) short;
using s16x4  = __attribute__((ext_vector_type(4))) short;
using f32x16 = __attribute__((ext_vector_type(16))) float;
using u32x4  = __attribute__((ext_vector_type(4))) unsigned;
constexpr int NW = 8, QBLK = 32, KVBLK = 64, NT = 66;
constexpr int LDQ = NQ  , LDK8 = MLA_H * QK_NOPE  , LDKR = 64  , LDO = DM;
constexpr int SHM_V = 128 * KVBLK, SHM_K = KVBLK * 128, SHM_KR = KVBLK * 64;
constexpr int OFF_V = 0, OFF_K = 2 * SHM_V, OFF_KR = OFF_K + 2 * SHM_K, OFF_WS = OFF_KR + 2 * SHM_KR, SHM_ATTN = OFF_WS + NW * 64 * 4;
constexpr float SCL = 1.0f / (F8S_Q * F8S_K);
constexpr float THRL = 0.0f, PSH = 8.0f;
typedef int i32x8 __attribute__((ext_vector_type(8)));
typedef float f32x2 __attribute__((ext_vector_type(2)));
typedef int i32x4 __attribute__((ext_vector_type(4)));
#define SBAR() __builtin_amdgcn_sched_barrier(0)
__device__ __forceinline__ int crow(int r, int hi) { return (r & 3) + 8 * (r >> 2) + 4 * hi; }
__device__ __forceinline__ unsigned cvtpk(float lo, float hi) { unsigned r; asm volatile("v_cvt_pk_bf16_f32 %0, %1, %2" : "=v"(r) : "v"(lo), "v"(hi)); return r; }

__device__ __forceinline__ void kmask(f32x16& p0, f32x16& p1, int tile, int hi) {
    const int kb = tile * KVBLK;
#pragma unroll
    for (int r = 0; r < 16; ++r) { const int k = kb + crow(r, hi); if (k >= LTOK) p0[r] = -1e30f; if (k + 32 >= LTOK) p1[r] = -1e30f; }
}
__device__ __forceinline__ void partialSM(f32x16& p0, f32x16& p1, float& m_reg, float& mn, float& alpha) {
    float pmax = p0[0];
#pragma unroll
    for (int r = 1; r < 16; ++r) pmax = fmaxf(pmax, p0[r]);
#pragma unroll
    for (int r = 0; r < 16; ++r) pmax = fmaxf(pmax, p1[r]);
    { auto rr = __builtin_amdgcn_permlane32_swap(__float_as_uint(pmax), __float_as_uint(pmax), false, false);
      pmax = fmaxf(__uint_as_float(rr[0]), __uint_as_float(rr[1])); }
    pmax *= SCL;
    if (__builtin_expect(__all(pmax - m_reg <= THRL), 1)) { mn = m_reg; alpha = 1.f; }
    else { mn = fmaxf(m_reg, pmax); alpha = __builtin_amdgcn_exp2f(m_reg - mn); m_reg = mn; }
    const float mn8 = PSH - mn; const f32x2 sc2 = {SCL, SCL}, m2 = {mn8, mn8};
#pragma unroll
    for (int r = 0; r < 16; r += 2) { f32x2 t = {p0[r], p0[r + 1]}; t = __builtin_elementwise_fma(t, sc2, m2); p0[r] = t[0]; p0[r + 1] = t[1]; }
#pragma unroll
    for (int r = 0; r < 16; r += 2) { f32x2 t = {p1[r], p1[r + 1]}; t = __builtin_elementwise_fma(t, sc2, m2); p1[r] = t[0]; p1[r + 1] = t[1]; }
#pragma unroll
    for (int r = 0; r < 16; ++r) p0[r] = __builtin_amdgcn_exp2f(p0[r]);
}
__device__ __forceinline__ void finishSM(f32x16& p0, f32x16& p1, float alpha, float& l_reg, i32x8& P8) {
#pragma unroll
    for (int r = 0; r < 16; ++r) p1[r] = __builtin_amdgcn_exp2f(p1[r]);
    f32x2 ps2 = {p0[0], p0[1]};
#pragma unroll
    for (int r = 2; r < 16; r += 2) ps2 += (f32x2){p0[r], p0[r + 1]};
#pragma unroll
    for (int r = 0; r < 16; r += 2) ps2 += (f32x2){p1[r], p1[r + 1]};
    float ps = ps2[0] + ps2[1];
    { auto rr = __builtin_amdgcn_permlane32_swap(__float_as_uint(ps), __float_as_uint(ps), false, false);
      ps = __uint_as_float(rr[0]) + __uint_as_float(rr[1]); }
    l_reg = l_reg * alpha + ps;
#pragma unroll
    for (int w = 0; w < 4; ++w) { int x = __builtin_amdgcn_cvt_pk_fp8_f32(p0[4 * w], p0[4 * w + 1], 0, false); P8[w] = __builtin_amdgcn_cvt_pk_fp8_f32(p0[4 * w + 2], p0[4 * w + 3], x, true); }
#pragma unroll
    for (int w = 0; w < 4; ++w) { int x = __builtin_amdgcn_cvt_pk_fp8_f32(p1[4 * w], p1[4 * w + 1], 0, false); P8[4 + w] = __builtin_amdgcn_cvt_pk_fp8_f32(p1[4 * w + 2], p1[4 * w + 3], x, true); }
}
template <int OFF> __device__ __forceinline__ bf16x8 lds_rd128(int addr) { bf16x8 r; asm volatile("ds_read_b128 %0, %1 offset:%2" : "=&v"(r) : "v"(addr), "i"(OFF) : "memory"); return r; }
#define LGKM_WAIT(n) asm volatile("s_waitcnt lgkmcnt(" #n ")" ::: "memory")
__device__ __forceinline__ void attn_unit(int b, int h, int q0, const unsigned char* __restrict__ Q8, const unsigned char* __restrict__ K8, const unsigned char* __restrict__ VT, const unsigned char* __restrict__ KR8, bf16* __restrict__ O, char* lds) {
    int tid_ = threadIdx.x; asm volatile("" : "+v"(tid_));
    const int tid = tid_, wid = __builtin_amdgcn_readfirstlane(tid >> 6), lane = tid & 63, r32 = lane & 31, hi = lane >> 5;
    char* V_lds = lds + OFF_V; char* K_lds = lds + OFF_K; char* KR_lds = lds + OFF_KR;
    float* ws = (float*)(lds + OFF_WS) + wid * 64; float* li_l = ws; float* al_l = ws + 32;
    float m_reg = -1e30f, l_reg = 0; f32x16 o[4] = {};
    const long kbase = (long)b * LTOK;
    const long rbase = (long)b * SEQ + q0 + wid * QBLK;
    i32x8 q8[3];
    { const unsigned char* Qw = Q8 + (rbase + r32) * LDQ + h * QK_D + hi * 32;
#pragma unroll
      for (int t = 0; t < 3; ++t) { const i32x4 lo = *reinterpret_cast<const i32x4*>(Qw + t * 64), hh = *reinterpret_cast<const i32x4*>(Qw + t * 64 + 16); q8[t] = (i32x8){lo[0], lo[1], lo[2], lo[3], hh[0], hh[1], hh[2], hh[3]}; } }
    const unsigned char* Kh = K8 + kbase * LDK8 + h * QK_NOPE; const unsigned char* Vh = VT + (size_t)(b * MLA_H + h) * NTV * SHM_V; const unsigned char* KRb = KR8 + kbase * LDKR;
    const int v_lds0 = (int)(uintptr_t)V_lds, k_lds0 = (int)(uintptr_t)K_lds, kr_lds0 = (int)(uintptr_t)KR_lds;
    int koff, voff, roff;
    { const int P = wid * 64 + lane, row = P >> 3, c = (P & 7) ^ (row & 7); koff = row * LDK8 + c * 16; }
    { const int P = wid * 64 + lane, d = P >> 2, c = (P & 3) ^ ((d >> 1) & 3); voff = d * 64 + c * 16; }
    { const int P = (wid & 3) * 64 + lane, row = P >> 2, c = (P & 3) ^ ((row >> 1) & 3); roff = row * LDKR + c * 16; }
    typedef __attribute__((address_space(3))) unsigned lds_u32;
#define DMA(t, bb) do { const unsigned char* kt_ = Kh + (long)(t) * KVBLK * LDK8; const unsigned char* vt_ = Vh + (long)(t) * SHM_V; const unsigned char* rt_ = KRb + (long)(t) * KVBLK * LDKR; \
    __builtin_amdgcn_global_load_lds((const unsigned*)(kt_ + koff), (lds_u32*)(K_lds + (bb) * SHM_K + wid * 1024), 16, 0, 0); \
    __builtin_amdgcn_global_load_lds((const unsigned*)(vt_ + voff), (lds_u32*)(V_lds + (bb) * SHM_V + wid * 1024), 16, 0, 0); \
    if (wid < 4) __builtin_amdgcn_global_load_lds((const unsigned*)(rt_ + roff), (lds_u32*)(KR_lds + (bb) * SHM_KR + wid * 1024), 16, 0, 0); } while (0)
#define RESC(a) do { if (__any((a) < 1.f)) { if (hi == 0) al_l[r32] = (a); asm volatile("s_waitcnt lgkmcnt(0)" ::: "memory"); \
    _Pragma("unroll") for (int d = 0; d < 4; ++d) _Pragma("unroll") for (int r = 0; r < 16; ++r) o[d][r] *= al_l[crow(r, hi)]; } } while (0)
    f32x16 p0, p1; float mn, al; i32x8 P8;
    DMA(0, 0);
    for (int j = 0; j < NT; ++j) {
        const int bb = j & 1;
        asm volatile("s_waitcnt vmcnt(0)" ::: "memory"); __syncthreads();
        if (j + 1 < NT) DMA(j + 1, bb ^ 1);
        int r32o = r32, hio = hi; asm volatile("" : "+v"(r32o), "+v"(hio));
        const int kad = k_lds0 + bb * SHM_K + r32o * 128 + ((hio * 32) ^ ((r32o & 7) << 4)), rad = kr_lds0 + bb * SHM_KR + r32o * 64 + ((hio * 32) ^ (((r32o >> 1) & 3) << 4));
        const int vad = v_lds0 + bb * SHM_V + r32o * 64 + ((hio * 32) ^ (((r32o >> 1) & 3) << 4)), vad1 = vad ^ 16;
        bf16x8 vf[4][2];
        bf16x8 f0[3][2], f1[3][2];
        { const int a0 = kad, a1 = kad ^ 16, a2 = kad ^ 64, a3 = kad ^ 64 ^ 16, a4 = rad, a5 = rad ^ 16;
          f0[0][0] = lds_rd128<0>(a0); f0[0][1] = lds_rd128<0>(a1); f1[0][0] = lds_rd128<32 * 128>(a0); f1[0][1] = lds_rd128<32 * 128>(a1);
          f0[1][0] = lds_rd128<0>(a2); f0[1][1] = lds_rd128<0>(a3); f1[1][0] = lds_rd128<32 * 128>(a2); f1[1][1] = lds_rd128<32 * 128>(a3);
          f0[2][0] = lds_rd128<0>(a4); f0[2][1] = lds_rd128<0>(a5); f1[2][0] = lds_rd128<32 * 64>(a4); f1[2][1] = lds_rd128<32 * 64>(a5); }
#define CAT8(x, y) ({ const i32x4 x_ = __builtin_bit_cast(i32x4, (x)), y_ = __builtin_bit_cast(i32x4, (y)); (i32x8){x_[0], x_[1], x_[2], x_[3], y_[0], y_[1], y_[2], y_[3]}; })
#define MMK(t_) do { p0 = __builtin_amdgcn_mfma_scale_f32_32x32x64_f8f6f4(CAT8(f0[t_][0], f0[t_][1]), q8[t_], p0, 0, 0, 0, 0, 0, 0); \
                     p1 = __builtin_amdgcn_mfma_scale_f32_32x32x64_f8f6f4(CAT8(f1[t_][0], f1[t_][1]), q8[t_], p1, 0, 0, 0, 0, 0, 0); } while (0)
        p0 = f32x16{}; p1 = f32x16{};
        LGKM_WAIT(8); SBAR(); MMK(0); SBAR();
        vf[0][0] = lds_rd128<0>(vad); vf[0][1] = lds_rd128<0>(vad1); vf[1][0] = lds_rd128<2048>(vad); vf[1][1] = lds_rd128<2048>(vad1);
        LGKM_WAIT(8); SBAR(); MMK(1); SBAR();
        LGKM_WAIT(4); SBAR(); MMK(2); SBAR();
#undef MMK
        if (j >= 64) kmask(p0, p1, j, hi);
        partialSM(p0, p1, m_reg, mn, al);
        finishSM(p0, p1, al, l_reg, P8); SBAR();
        RESC(al);
        LGKM_WAIT(0);
        vf[2][0] = lds_rd128<4096>(vad); vf[2][1] = lds_rd128<4096>(vad1); vf[3][0] = lds_rd128<6144>(vad); vf[3][1] = lds_rd128<6144>(vad1);
#define PVM(d_) o[d_] = __builtin_amdgcn_mfma_scale_f32_32x32x64_f8f6f4(P8, CAT8(vf[d_][0], vf[d_][1]), o[d_], 0, 0, 0, 0, 0, 0)
        SBAR(); PVM(0); PVM(1); SBAR();
        LGKM_WAIT(0); SBAR(); PVM(2); PVM(3); SBAR();
#undef PVM
    }
    if (hi == 0) li_l[r32] = l_reg; asm volatile("s_waitcnt lgkmcnt(0)" ::: "memory");
    float rli[16];
#pragma unroll
    for (int r = 0; r < 16; ++r) rli[r] = __builtin_amdgcn_rcpf(li_l[crow(r, hi)] * F8S_V);
    int hie = hi; asm volatile("" : "+v"(hie));
    unsigned char* Ow = (unsigned char*)O + rbase * LDO + h * V_D + r32;
#pragma unroll
    for (int r = 0; r < 16; ++r) { const int orow = crow(r, hie);
#pragma unroll
        for (int d0 = 0; d0 < 4; ++d0) { const float v = f8c(o[d0][r] * (rli[r] * F8S_O)); Ow[orow * LDO + d0 * 32] = (unsigned char)__builtin_amdgcn_cvt_pk_fp8_f32(v, v, 0, false); } }
    __syncthreads();
#undef DMA
#undef RESC
#undef CAT8
#undef LGKM_WAIT
}
#undef KSWZ
#undef KRSWZ
#undef SBAR
}

struct Ctx { int tid, lane, wave, G, vcu, gw, NGW; LAS unsigned char* lds; };

template <int MODE> __device__ __forceinline__ int map_row(int n, int row_off) {
    if (MODE == 1) { if (n < 1024) return row_off + n; const int m = n - 1024; return row_off + 1024 + (m < 416 ? m : (m < 1440 ? m + 96 : m - 1024)); }
    if (MODE == 2) { const int h = n / QK_D, j = n - h * QK_D; if (j < QK_NOPE) return n; const int i = j - QK_NOPE; return h * QK_D + QK_NOPE + ((i < 32) ? 2 * i : 2 * (i - 32) + 1); }
    return n + row_off;
}
template <int MODE, bool F8 = false> __device__ __forceinline__ void transpose_item(const float* W, int ldw, int col_src0, int K, int nblk, bf16* WT, int row_off, LAS float* scr, int item, int lane) {
    const int kb = item / nblk, nb = item % nblk, k0 = 64 * kb, n0 = 32 * nb;
#pragma unroll 8
    for (int i = 0; i < 32; ++i) { const int kk = 2 * i + (lane >> 5); scr[kk * 33 + (lane & 31)] = W[(size_t)(k0 + kk) * ldw + col_src0 + n0 + (lane & 31)]; }
    LDS_WAIT(); asm volatile("" ::: "memory");
    const int c = lane & 7;
#pragma unroll
    for (int j = 0; j < 4; ++j) { const int n = (lane >> 3) + 8 * j; const LAS float* s = scr + (8 * c) * 33 + n;
        if constexpr (F8) {
            v2u o8; o8.x = pk4_f8(s[0 * 33] * F8S_W, s[1 * 33] * F8S_W, s[2 * 33] * F8S_W, s[3 * 33] * F8S_W); o8.y = pk4_f8(s[4 * 33] * F8S_W, s[5 * 33] * F8S_W, s[6 * 33] * F8S_W, s[7 * 33] * F8S_W);
            *(v2u*)((unsigned char*)WT + (size_t)map_row<MODE>(n0 + n, row_off) * K + k0 + 8 * c) = o8; continue; }
        v4u o; o.x = pk2(s[0 * 33], s[1 * 33]); o.y = pk2(s[2 * 33], s[3 * 33]); o.z = pk2(s[4 * 33], s[5 * 33]); o.w = pk2(s[6 * 33], s[7 * 33]);
        *(v4u*)(WT + (size_t)map_row<MODE>(n0 + n, row_off) * K + k0 + 8 * c) = o; }
    LDS_WAIT(); asm volatile("" ::: "memory");
}

constexpr int DI_G = 32 * 128, DI_UQ = 8 * 96, DI_UKV = 8 * 128, DI_PR = 16 * 64, DI_PM = 32 * 64, DI_O = 32 * 64, NDEF = DI_G + DI_UQ + DI_UKV + DI_PR + DI_PM + DI_O;
struct DefItem { const float* W; unsigned char* WT; int ldw, col0, K, k0, n0, rope; };
__device__ __forceinline__ void def_decode(const Args& a, int d, DefItem& it) {
    unsigned char* ws = a.ws; int r = d, nblk; it.rope = 0;
    if (r < DI_G) { it.W = a.in[I_WIN]; it.ldw = 8672; it.col0 = 4576; it.K = DM; nblk = 128; it.WT = ws + WS_WG; }
    else if ((r -= DI_G) < DI_UQ) { it.W = a.in[I_WUQ]; it.ldw = NQ; it.col0 = 0; it.K = 512; nblk = 96; it.WT = ws + WS_WUQ; it.rope = 1; }
    else if ((r -= DI_UQ) < DI_UKV) { it.W = a.in[I_WUKV]; it.ldw = NKV; it.col0 = 0; it.K = 512; nblk = 128; it.WT = ws + WS_WUKV; }
    else if ((r -= DI_UKV) < DI_PR) { it.W = a.in[I_PRW]; it.ldw = DM; it.col0 = 0; it.K = 1024; nblk = 64; it.WT = ws + WS_WPR; }
    else if ((r -= DI_PR) < DI_PM) { it.W = a.in[I_PMLA]; it.ldw = DM; it.col0 = 0; it.K = 2048; nblk = 64; it.WT = ws + WS_WPM; }
    else { r -= DI_PM; it.W = a.in[I_WO]; it.ldw = DM; it.col0 = 0; it.K = 2048; nblk = 64; it.WT = ws + WS_WO; }
    const int kb = r / nblk, nb = r - kb * nblk; it.k0 = 64 * kb; it.n0 = 32 * nb;
}
__device__ __forceinline__ void def_issue(const DefItem& it, int lane, float (&tv)[32]) {
#pragma unroll
    for (int i = 0; i < 32; ++i) { const int kk = 2 * i + (lane >> 5); tv[i] = it.W[(size_t)(it.k0 + kk) * it.ldw + it.col0 + it.n0 + (lane & 31)]; }
}
__device__ __forceinline__ void def_finish(const DefItem& it, LAS float* scr, int lane, const float (&tv)[32]) {
#pragma unroll
    for (int i = 0; i < 32; ++i) { const int kk = 2 * i + (lane >> 5); scr[kk * 33 + (lane & 31)] = tv[i]; }
    LDS_WAIT(); asm volatile("" ::: "memory");
    const int c = lane & 7;
#pragma unroll
    for (int j = 0; j < 4; ++j) { const int n = (lane >> 3) + 8 * j; const LAS float* s = scr + (8 * c) * 33 + n;
        v2u o8; o8.x = pk4_f8(s[0 * 33] * F8S_W, s[1 * 33] * F8S_W, s[2 * 33] * F8S_W, s[3 * 33] * F8S_W); o8.y = pk4_f8(s[4 * 33] * F8S_W, s[5 * 33] * F8S_W, s[6 * 33] * F8S_W, s[7 * 33] * F8S_W);
        const int row = it.rope ? map_row<2>(it.n0 + n, 0) : it.n0 + n;
        *(v2u*)(it.WT + (size_t)row * it.K + it.k0 + 8 * c) = o8; }
    LDS_WAIT(); asm volatile("" ::: "memory");
}

__device__ __forceinline__ void xn_row(const Args& a, const Ctx& C, int m, const float* g, bf16* XN, bf16* XNR, unsigned char* XN8T) {
    unsigned long long* o8 = (unsigned long long*)(XN + (size_t)m * DM) + C.lane;
    unsigned* t8 = (unsigned*)(XN8T + (size_t)m * DM) + C.lane;
    if (m >= TOK) {
#pragma unroll
        for (int j = 0; j < 8; ++j) { o8[64 * j] = 0ull; t8[64 * j] = 0u; }
        return; }
    const int bb = m / LTOK, l = m - bb * LTOK;
    const float* src = (l < NMETA) ? a.in[I_META] + (size_t)l * DM : a.in[I_X] + ((size_t)bb * SEQ + (l - NMETA)) * DM;
    const f32x4v* xr = (const f32x4v*)src + C.lane; const f32x4v* gr = (const f32x4v*)g + C.lane;
    f32x4v v[8]; float s = 0.f;
#pragma unroll
    for (int j = 0; j < 8; ++j) { v[j] = xr[64 * j]; s += (v[j].x * v[j].x + v[j].y * v[j].y) + (v[j].z * v[j].z + v[j].w * v[j].w); }
    const float rstd = 1.0f / sqrtf(wave_sum(s) * (1.f / DM) + NORM_EPS);
    unsigned* r8 = (l >= NMETA) ? (unsigned*)((unsigned char*)XNR + ((size_t)bb * SEQ + (l - NMETA)) * DM) + C.lane : nullptr;
#pragma unroll
    for (int j = 0; j < 8; ++j) { const f32x4v gg = gr[64 * j]; const float e0 = v[j].x * rstd * gg.x, e1 = v[j].y * rstd * gg.y, e2 = v[j].z * rstd * gg.z, e3 = v[j].w * rstd * gg.w;
        o8[64 * j] = (unsigned long long)pk2(e0, e1) | ((unsigned long long)pk2(e2, e3) << 32);
        const unsigned w8 = pk4_f8(e0 * F8S_XN, e1 * F8S_XN, e2 * F8S_XN, e3 * F8S_XN); t8[64 * j] = w8; if (r8) r8[64 * j] = w8; }
}

__device__ __forceinline__ void xn_row_real(const Args& a, const Ctx& C, int r, const float* g, bf16* XN) {
    unsigned long long* o8 = (unsigned long long*)(XN + (size_t)r * DM) + C.lane;
    const f32x4v* xr = (const f32x4v*)(a.in[I_X] + (size_t)r * DM) + C.lane; const f32x4v* gr = (const f32x4v*)g + C.lane;
    f32x4v v[8]; float s = 0.f;
#pragma unroll
    for (int j = 0; j < 8; ++j) { v[j] = xr[64 * j]; s += (v[j].x * v[j].x + v[j].y * v[j].y) + (v[j].z * v[j].z + v[j].w * v[j].w); }
    const float rstd = 1.0f / sqrtf(wave_sum(s) * (1.f / DM) + NORM_EPS);
#pragma unroll
    for (int j = 0; j < 8; ++j) { const f32x4v gg = gr[64 * j];
        o8[64 * j] = (unsigned long long)pk2(v[j].x * rstd * gg.x, v[j].y * rstd * gg.y) | ((unsigned long long)pk2(v[j].z * rstd * gg.z, v[j].w * rstd * gg.w) << 32); }
}

__device__ __forceinline__ void sincos_acc(float ang, float& s, float& c) {
    const double a = (double)ang;
    const double kq = rint(a * 0.6366197723675814);
    const double r = (a - kq * 1.5707963267948966) - kq * 6.123233995736766e-17;
    const int q = ((int)kq) & 3;
    const double r2 = r * r;
    const double sp = r * (1.0 + r2 * (-1.6666666666666666e-1 + r2 * (8.333333333333333e-3 + r2 * (-1.984126984126984e-4 + r2 * (2.7557319223985893e-6 + r2 * (-2.505210838544172e-8))))));
    const double cp = 1.0 + r2 * (-0.5 + r2 * (4.1666666666666664e-2 + r2 * (-1.388888888888889e-3 + r2 * (2.48015873015873e-5 + r2 * (-2.755731922398589e-7 + r2 * 2.08767569878681e-9)))));
    const double sv = (q & 1) ? cp : sp, cv = (q & 1) ? sp : cp;
    s = (float)((q & 2) ? -sv : sv); c = (float)(((q + 1) & 2) ? -cv : cv);
}

__device__ __forceinline__ void p0_prologue(const Args& a, const Ctx& C) {
    unsigned char* ws = a.ws;
    LAS float* scr = (LAS float*)(C.lds + C.wave * 16384);
    constexpr int I_IN = 32 * 32, I_INR = 32 * 32, I_INB = 32 * 79, NIT = I_IN + I_INR + I_INB;
    for (int it = C.gw; it < NIT; it += C.NGW) {
        int r = it;
        if (r < I_IN) { transpose_item<0>(a.in[I_WIN], 8672, 1024, DM, 32, (bf16*)(ws + WS_WIN), 0, scr, r, C.lane); continue; } r -= I_IN;
        if (r < I_INR) { transpose_item<0, true>(a.in[I_WIN], 8672, 0, DM, 32, (bf16*)(ws + WS_WIN8), 0, scr, r, C.lane); continue; } r -= I_INR;
        transpose_item<1, true>(a.in[I_WIN], 8672, 2048, DM, 79, (bf16*)(ws + WS_WIN8), 1024, scr, r, C.lane);
    }
    const long gt = (long)C.gw * 64 + C.lane, NGT = (long)C.NGW * 64;
    {
        unsigned char* W = ws + WS_WIN8;
        for (long i = gt; i < 32L * 128; i += NGT) { const int rr = (int)(i >> 7), c16 = (int)(i & 127); *(v4u*)(W + (size_t)(2528 + rr) * DM + c16 * 16) = (v4u){0u, 0u, 0u, 0u}; }
    }
    {
        bf16* Wg = (bf16*)(ws + WS_WLG); bf16* Ww = (bf16*)(ws + WS_WLW);
        for (long i = gt; i < 5120L * 32; i += NGT) { const int n = (int)(i >> 5), k0 = (int)(i & 31) * 8; const int seg = n >> 10, nn = n & 1023;
            float v[8];
#pragma unroll
            for (int e = 0; e < 8; ++e) { const int k = k0 + e; float x = 0.f;
                if (seg == 0) { if (k < 160) x = a.in[I_GUP][(size_t)k * 1024 + nn]; }
                else { const int sl = seg - 1, kk = k - 64 * sl; if (kk >= 0 && kk < 64) x = (sl < 2 ? a.in[I_WUP] : a.in[I_AUP])[(size_t)(64 * (sl & 1) + kk) * 1024 + nn]; }
                v[e] = x; }
            v4u o; o.x = pk2(v[0], v[1]); o.y = pk2(v[2], v[3]); o.z = pk2(v[4], v[5]); o.w = pk2(v[6], v[7]);
            if (seg == 0) *(v4u*)(Wg + (size_t)nn * 256 + k0) = o; else *(v4u*)(Ww + (size_t)(n - 1024) * 256 + k0) = o; }
    }
    {
        bf16* A = (bf16*)(ws + WS_AFULL); bf16* Wq = (bf16*)(ws + WS_WQBF);
        for (long i = gt; i < 2048L * 256; i += NGT) { const int row = (int)(i >> 8), c0 = (int)(i & 255) * 8; const int hp = row >> 7, n = row & 127;
            v4u o = (v4u){0u, 0u, 0u, 0u};
            if ((c0 >> 7) == hp) { const float* s = a.in[I_PKEYS] + ((size_t)hp * 128 + n) * 128 + (c0 & 127); const f32x4v x = *(const f32x4v*)s, y = *(const f32x4v*)(s + 4);
                o.x = pk2(x.x, x.y); o.y = pk2(x.z, x.w); o.z = pk2(y.x, y.y); o.w = pk2(y.z, y.w); }
            *(v4u*)(A + (size_t)row * DM + c0) = o;
            const float* s2 = a.in[I_PWQ] + (size_t)row * DM + c0; const f32x4v x = *(const f32x4v*)s2, y = *(const f32x4v*)(s2 + 4);
            v4u q; q.x = pk2(x.x, x.y); q.y = pk2(x.z, x.w); q.z = pk2(y.x, y.y); q.w = pk2(y.z, y.w);
            *(v4u*)(Wq + (size_t)row * DM + c0) = q; }
    }
    {
        float* ct = (float*)(ws + WS_ROPE); float* st = (float*)(ws + WS_ROPE + MiB);
        for (long i = gt; i < (long)LTOK * 32; i += NGT) { const int l = (int)(i >> 5), f = (int)(i & 31);
            const float inv = (float)exp2(-(double)f * (13.287712379549449 / 32.0));
            const float ang = (float)l * inv; float s, c; sincos_acc(ang, s, c); ct[i] = c; st[i] = s; }
    }
    for (int m = C.gw; m < TP; m += C.NGW) xn_row(a, C, m, a.in[I_NMG], (bf16*)(ws + WS_XN), (bf16*)a.out, ws + WS_XN8T);
}

__device__ __forceinline__ void p2_mla_prep(const Args& a, const Ctx& C) {
    unsigned char* ws = a.ws;
    const bf16* P = (const bf16*)(ws + WS_PROJ); bf16* QN = (bf16*)(ws + WS_QN); bf16* KVN = (bf16*)(ws + WS_KVN); bf16* KR = (bf16*)(ws + WS_KR);
    const float* ct = (const float*)(ws + WS_ROPE); const float* st = (const float*)(ws + WS_ROPE + MiB);
    constexpr int RB = 4;
    for (int m0 = C.gw; m0 < TP; m0 += RB * C.NGW) {
        v4u tq[RB], tk[RB]; unsigned short k1[RB], k2[RB]; float cc[RB], ss[RB];
#pragma unroll
        for (int i = 0; i < RB; ++i) { const int m = m0 + i * C.NGW; if (m < TP) { const bf16* pr = P + (size_t)m * NPROJ;
            tq[i] = *(const v4u*)(pr + C_QD + C.lane * 8); tk[i] = *(const v4u*)(pr + C_KVD + C.lane * 8);
            const int l = (m < TOK) ? m % LTOK : 0; const int lr = C.lane & 31;
            k1[i] = pr[C_KR + lr]; k2[i] = pr[C_KR + 32 + lr]; cc[i] = ct[l * 32 + lr]; ss[i] = st[l * 32 + lr]; } }
#pragma unroll
        for (int i = 0; i < RB; ++i) { const int m = m0 + i * C.NGW; if (m < TP) {
#pragma unroll
            for (int which = 0; which < 2; ++which) {
                const v4u t = which ? tk[i] : tq[i];
                float v[8] = {bf_lo(t.x), bf_hi(t.x), bf_lo(t.y), bf_hi(t.y), bf_lo(t.z), bf_hi(t.z), bf_lo(t.w), bf_hi(t.w)};
                float s = 0.f;
#pragma unroll
                for (int e = 0; e < 8; ++e) s += v[e] * v[e];
                const float rstd = 1.0f / sqrtf(wave_sum(s) * (1.f / 512.f) + NORM_EPS);
                const float* g = a.in[which ? I_KVNG : I_QNG] + C.lane * 8;
                const float rs8 = rstd * F8S_XN;
                v2u o; o.x = pk4_f8(v[0] * rs8 * g[0], v[1] * rs8 * g[1], v[2] * rs8 * g[2], v[3] * rs8 * g[3]); o.y = pk4_f8(v[4] * rs8 * g[4], v[5] * rs8 * g[5], v[6] * rs8 * g[6], v[7] * rs8 * g[7]);
                if (which) *(v2u*)((unsigned char*)KVN + (size_t)m * 512 + C.lane * 8) = o;
                else if (m < TOK) { const int bb = m / LTOK, l = m - bb * LTOK; if (l >= NMETA) *(v2u*)((unsigned char*)QN + ((size_t)bb * SEQ + (l - NMETA)) * 512 + C.lane * 8) = o; }
            }
            if (C.lane < 32) {
                const float x1 = bf2f(k1[i]), x2 = bf2f(k2[i]);
                *(unsigned short*)((unsigned char*)KR + (size_t)m * 64 + 2 * C.lane) = (unsigned short)__builtin_amdgcn_cvt_pk_fp8_f32(f8c((x1 * cc[i] - x2 * ss[i]) * F8S_K), f8c((x1 * ss[i] + x2 * cc[i]) * F8S_K), 0, false);
            } } }
    }
}

__device__ __forceinline__ void final_norm_rows(const Args& a, const Ctx& C, const float* H) {
    const float* g = a.in[I_FNG];
    for (int r = C.gw; r < BATCH * SEQ; r += C.NGW) {
        const int bb = r / SEQ, t = r - bb * SEQ, m = bb * LTOK + NMETA + t;
        const f32x4v* xr = (const f32x4v*)(H + (size_t)m * DM) + C.lane; const f32x4v* gr = (const f32x4v*)g + C.lane;
        f32x4v v[8]; float s = 0.f;
#pragma unroll
        for (int j = 0; j < 8; ++j) { v[j] = xr[64 * j]; s += (v[j].x * v[j].x + v[j].y * v[j].y) + (v[j].z * v[j].z + v[j].w * v[j].w); }
        const float rstd = 1.0f / sqrtf(wave_sum(s) * (1.f / DM) + NORM_EPS);
        f32x4v* o = (f32x4v*)(a.out + (size_t)r * DM) + C.lane;
#pragma unroll
        for (int j = 0; j < 8; ++j) { const f32x4v gg = gr[64 * j]; o[64 * j] = v[j] * rstd * gg; }
    }
}

__device__ __forceinline__ void p2_rwkv_prep(const Args& a, const Ctx& C) {
    unsigned char* ws = a.ws;
    const bf16* P = (const bf16*)(ws + WS_PROJ); bf16* RKV = (bf16*)(ws + WS_RKV); bf16* AW = (bf16*)(ws + WS_AW); bf16* AG = (bf16*)(ws + WS_AG);
    const float* sc = a.in[I_SHIFT];
    constexpr int RS = 8, NSTRIP = TP / RS;
    for (int item = C.gw; item < NSTRIP * 7; item += C.NGW) {
        const int strip = item / 7, it = item - strip * 7;
        const int ch = it * 64 + C.lane, c0 = ch * 8;
        if (ch >= 448) continue;
        const int m0 = strip * RS;
        if (ch >= 436) {
#pragma unroll 1
            for (int q = 0; q < RS; ++q) { const int m = m0 + q; if (m < TOK) { const int bb = m / LTOK, l = m - bb * LTOK; if (l >= NMETA) *(v4u*)(AG + ((size_t)bb * SEQ + (l - NMETA)) * 256 + 160 + (ch - 436) * 8) = (v4u){0u, 0u, 0u, 0u}; } }
            continue; }
        const f32x4v s0a = *(const f32x4v*)(sc + c0), s0b = *(const f32x4v*)(sc + c0 + 4);
        const f32x4v s1a = *(const f32x4v*)(sc + 3488 + c0), s1b = *(const f32x4v*)(sc + 3488 + c0 + 4);
        const f32x4v s2a = *(const f32x4v*)(sc + 2 * 3488 + c0), s2b = *(const f32x4v*)(sc + 2 * 3488 + c0 + 4);
        const v4u zero4 = (v4u){0u, 0u, 0u, 0u};
        v4u rowv[RS + 2];
#pragma unroll
        for (int q = 0; q < RS + 2; ++q) { const int m = m0 - 1 + q; rowv[q] = (m >= 0 && m < TOK) ? *(const v4u*)(P + (size_t)m * NPROJ + c0) : zero4; }
#pragma unroll
        for (int q = 0; q < RS; ++q) {
            const int m = m0 + q;
            const v4u pv = rowv[q], cu = rowv[q + 1], nv = rowv[q + 2];
            const bool valid = m < TOK; const int bb = valid ? m / LTOK : 0, l = m - bb * LTOK;
            const v4u pz = (valid && l > 0) ? pv : zero4, nz = (valid && l < LTOK - 1) ? nv : zero4;
            v4u o = zero4;
            if (valid) {
                float x[8];
                x[0] = s0a.x * bf_lo(pz.x) + s1a.x * bf_lo(cu.x) + s2a.x * bf_lo(nz.x); x[1] = s0a.y * bf_hi(pz.x) + s1a.y * bf_hi(cu.x) + s2a.y * bf_hi(nz.x);
                x[2] = s0a.z * bf_lo(pz.y) + s1a.z * bf_lo(cu.y) + s2a.z * bf_lo(nz.y); x[3] = s0a.w * bf_hi(pz.y) + s1a.w * bf_hi(cu.y) + s2a.w * bf_hi(nz.y);
                x[4] = s0b.x * bf_lo(pz.z) + s1b.x * bf_lo(cu.z) + s2b.x * bf_lo(nz.z); x[5] = s0b.y * bf_hi(pz.z) + s1b.y * bf_hi(cu.z) + s2b.y * bf_hi(nz.z);
                x[6] = s0b.z * bf_lo(pz.w) + s1b.z * bf_lo(cu.w) + s2b.z * bf_lo(nz.w); x[7] = s0b.w * bf_hi(pz.w) + s1b.w * bf_hi(cu.w) + s2b.w * bf_hi(nz.w);
                if (ch >= 384 && ch < 404) {
#pragma unroll
                    for (int e = 0; e < 8; ++e) x[e] = sigmoidf_(x[e]);
                } else if (ch >= 404 && ch < 420) {
#pragma unroll
                    for (int e = 0; e < 8; ++e) x[e] = 1.0f - 2.0f / (1.0f + __expf(2.0f * x[e]));
                }
                o.x = pk2(x[0], x[1]); o.y = pk2(x[2], x[3]); o.z = pk2(x[4], x[5]); o.w = pk2(x[6], x[7]);
            }
            if (ch < 384) *(v4u*)(RKV + (size_t)m * 3072 + c0) = o;
            else if (ch < 404) { if (valid && l >= NMETA) *(v4u*)(AG + ((size_t)bb * SEQ + (l - NMETA)) * 256 + (ch - 384) * 8) = o; }
            else *(v4u*)(AW + (size_t)m * 256 + (ch - 404) * 8) = o;
        }
    }
}

struct TabRow { f32x4v x[8]; };
__device__ __forceinline__ void tab_issue(const Args& a, int rw, int lane, TabRow& t) {
    const bool second = rw >= 16384; const int e = second ? rw - 16384 : rw;
    const float* src = a.in[second ? I_PV : I_PU] + (size_t)e * DM + lane * 4;
#pragma unroll
    for (int j = 0; j < 8; ++j) t.x[j] = *(const f32x4v*)(src + j * 256);
}
__device__ __forceinline__ void tab_finish(const Args& a, int rw, int lane, const TabRow& t) {
    const bool second = rw >= 16384; const int e = second ? rw - 16384 : rw;
    float mx = 0.f;
#pragma unroll
    for (int j = 0; j < 8; ++j) mx = fmaxf(mx, fmaxf(fmaxf(fabsf(t.x[j].x), fabsf(t.x[j].y)), fmaxf(fabsf(t.x[j].z), fabsf(t.x[j].w))));
    const unsigned sb = pk2(fmaxf(mx, 1e-30f) * (1.0f / 6.0f), 0.f) & 0xffffu;
    const float inv = 1.0f / bf_lo(sb);
    v4u o;
#pragma unroll
    for (int m = 0; m < 4; ++m) { unsigned w = 0u;
        w = __builtin_amdgcn_cvt_scalef32_pk_fp4_f32(w, t.x[2 * m][0] * inv, t.x[2 * m + 1][0] * inv, 1.0f, 0);
        w = __builtin_amdgcn_cvt_scalef32_pk_fp4_f32(w, t.x[2 * m][1] * inv, t.x[2 * m + 1][1] * inv, 1.0f, 1);
        w = __builtin_amdgcn_cvt_scalef32_pk_fp4_f32(w, t.x[2 * m][2] * inv, t.x[2 * m + 1][2] * inv, 1.0f, 2);
        w = __builtin_amdgcn_cvt_scalef32_pk_fp4_f32(w, t.x[2 * m][3] * inv, t.x[2 * m + 1][3] * inv, 1.0f, 3);
        o[m] = w; }
    unsigned char* dst = a.ws + (second ? WS_VQ : WS_UQ) + (size_t)e * TROW;
    *(v4u*)(dst + lane * 16) = o;
    *(unsigned short*)(dst + 1024 + lane * 2) = (unsigned short)sb;
}

namespace scan {
constexpr int TC = 16, NC = LTOK / TC;
static_assert(NC * TC == LTOK, "chunking");
constexpr int BUF_BYTES = 5 * TC * 64 * 4 + TC * 32 * 4;
constexpr int OFF_W = 0, OFF_A = TC * 256, OFF_B = 2 * TC * 256, OFF_KT = 3 * TC * 256, OFF_R = 4 * TC * 256, OFF_V = 5 * TC * 256;
constexpr int OFF_Y = 2 * BUF_BYTES, YB_BYTES = TC * 16 * 16 * 8;
typedef float f32x2v __attribute__((ext_vector_type(2)));
template <int CTRL> __device__ __forceinline__ float dpp_add(float x) { return x + __int_as_float(__builtin_amdgcn_update_dpp(0, __float_as_int(x), CTRL, 0xf, 0xf, false)); }
__device__ __forceinline__ float row16_sum(float x) { x = dpp_add<0x128>(x); x = dpp_add<0x124>(x); x = dpp_add<0x122>(x); x = dpp_add<0x121>(x); return x; }

struct PLoad { v2u r, k, om, ic; unsigned v; };
struct SOps { f32x4v w, a, b, t, r; f32x2v v; };

__device__ __forceinline__ void scan_item(const Args& a, const Ctx& C, int item) {
    unsigned char* ws = a.ws;
    const bf16* RKV = (const bf16*)(ws + WS_RKV); const bf16* OMIC = (const bf16*)(ws + WS_OMIC); bf16* Y = (bf16*)(ws + WS_Y);
    const int chain = item >> 1, half = item & 1, b = chain >> 5, h = (chain >> 1) & 15, dir = chain & 1;
    const bf16* OM = OMIC + (size_t)dir * TP * 1024; const bf16* IC = OMIC + (size_t)(2 + dir) * TP * 1024; bf16* Yd = Y + (size_t)dir * TP * 1024;
    LAS unsigned char* L = C.lds;
    const int tid = C.tid;
    const bool producer = tid >= 256;
    const int pt = tid & 255;
    const int ps = pt >> 4, pc = (pt & 15) * 4, pvr = (pt & 15) * 2;
    float kkc[4], kac[4];
#pragma unroll
    for (int e = 0; e < 4; ++e) { kkc[e] = a.in[I_KK][h * 64 + pc + e]; kac[e] = a.in[I_KA][h * 64 + pc + e]; }
    const int rp = pt >> 4, cg = pt & 15;
    f32x2v S0a = {0.f, 0.f}, S0b = {0.f, 0.f}, S1a = {0.f, 0.f}, S1b = {0.f, 0.f};
    int xrow = 1 << 30;
    float dtv[32]; DefItem dit; int dcur = 1 << 30; LAS float* dscr = (LAS float*)(L + OFF_Y + 2 * YB_BYTES) + ((tid >> 6) & 3) * (64 * 33);
    TabRow trow; int trw = 1 << 30; const int lane_ = tid & 63, trow0 = item * 4 + ((tid >> 6) & 3), tstride = 256 * 4;
    PLoad ldA, ldB;
#define tok_row(c, s) ((long)b * LTOK + (dir ? (LTOK - 1 - ((c) * TC + (s))) : ((c) * TC + (s))))
#define P_ISSUE(ld, c) do { if ((c) < NC) { const long m_ = tok_row((c), ps); const bf16* rk = RKV + m_ * 3072 + h * 64 + pc; \
        ld.r = *(const v2u*)rk; ld.k = *(const v2u*)(rk + 1024); ld.v = *(const unsigned*)(RKV + m_ * 3072 + 2048 + h * 64 + half * 32 + pvr); \
        ld.om = *(const v2u*)(OM + m_ * 1024 + h * 64 + pc); ld.ic = *(const v2u*)(IC + m_ * 1024 + h * 64 + pc); } } while (0)
#define P_STAGE(ld, c) do { if ((c) < NC) { LAS unsigned char* B_ = L + ((c) & 1) * BUF_BYTES; \
        const float r_[4] = {bf_lo(ld.r.x), bf_hi(ld.r.x), bf_lo(ld.r.y), bf_hi(ld.r.y)}; \
        const float k_[4] = {bf_lo(ld.k.x), bf_hi(ld.k.x), bf_lo(ld.k.y), bf_hi(ld.k.y)}; \
        const float o_[4] = {bf_lo(ld.om.x), bf_hi(ld.om.x), bf_lo(ld.om.y), bf_hi(ld.om.y)}; \
        const float i_[4] = {bf_lo(ld.ic.x), bf_hi(ld.ic.x), bf_lo(ld.ic.y), bf_hi(ld.ic.y)}; \
        float kk_[4]; float ss_ = 0.f; \
        _Pragma("unroll") for (int e = 0; e < 4; ++e) { kk_[e] = k_[e] * kkc[e]; ss_ += kk_[e] * kk_[e]; } \
        ss_ = row16_sum(ss_); \
        const float inv_ = __builtin_amdgcn_rsqf(fmaxf(ss_, 1e-24f));     \
        float w_[4], a_[4], b_[4], t_[4]; \
        _Pragma("unroll") for (int e = 0; e < 4; ++e) { kk_[e] *= inv_; w_[e] = 1.0f - o_[e]; a_[e] = -kk_[e]; b_[e] = kk_[e] * i_[e]; t_[e] = k_[e] * (1.0f + (i_[e] - 1.0f) * kac[e]); } \
        const int o2_ = ps * 256 + pc * 4; \
        *(LAS f32x4v*)(B_ + OFF_W + o2_) = (f32x4v){w_[0], w_[1], w_[2], w_[3]}; \
        *(LAS f32x4v*)(B_ + OFF_A + o2_) = (f32x4v){a_[0], a_[1], a_[2], a_[3]}; \
        *(LAS f32x4v*)(B_ + OFF_B + o2_) = (f32x4v){b_[0], b_[1], b_[2], b_[3]}; \
        *(LAS f32x4v*)(B_ + OFF_KT + o2_) = (f32x4v){t_[0], t_[1], t_[2], t_[3]}; \
        *(LAS f32x4v*)(B_ + OFF_R + o2_) = (f32x4v){r_[0], r_[1], r_[2], r_[3]}; \
        *(LAS f32x2v*)(B_ + OFF_V + ps * 128 + pvr * 4) = (f32x2v){bf_lo(ld.v), bf_hi(ld.v)}; } } while (0)
#define P_YOUT(c) do { if ((c) >= 0) { const LAS unsigned char* YB_ = L + OFF_Y + ((c) & 1) * YB_BYTES + (ps * 16 + (pt & 15)) * 128; \
        f32x4v s_ = *(const LAS f32x4v*)YB_; \
        _Pragma("unroll") for (int q = 1; q < 8; ++q) s_ += *(const LAS f32x4v*)(YB_ + q * 16); \
        *(unsigned*)(Yd + tok_row((c), ps) * 1024 + h * 64 + half * 32 + pvr) = pk2(s_.x + s_.z, s_.y + s_.w); } } while (0)
#define S_LOAD(o, Bc, s) do { const int o4_ = (s) * 256 + cg * 16; \
        o.w = *(const volatile LAS f32x4v*)(Bc + OFF_W + o4_); o.a = *(const volatile LAS f32x4v*)(Bc + OFF_A + o4_); o.b = *(const volatile LAS f32x4v*)(Bc + OFF_B + o4_); \
        o.t = *(const volatile LAS f32x4v*)(Bc + OFF_KT + o4_); o.r = *(const volatile LAS f32x4v*)(Bc + OFF_R + o4_); o.v = *(const volatile LAS f32x2v*)(Bc + OFF_V + (s) * 128 + rp * 8); } while (0)
#define S_Y(o, YBc, s) do { const f32x2v r01 = {o.r.x, o.r.y}, r23 = {o.r.z, o.r.w}; \
        f32x2v y0 = S0a * r01; y0 = S0b * r23 + y0; f32x2v y1 = S1a * r01; y1 = S1b * r23 + y1; \
        *(LAS f32x2v*)(YBc + ((s) * 16 + rp) * 128 + cg * 8) = (f32x2v){y0.x + y0.y, y1.x + y1.y}; } while (0)
#define S_STEP(o, op, YBc, s) do { \
        const f32x2v a01 = {o.a.x, o.a.y}, a23 = {o.a.z, o.a.w}, w01 = {o.w.x, o.w.y}, w23 = {o.w.z, o.w.w}, b01 = {o.b.x, o.b.y}, b23 = {o.b.z, o.b.w}; \
        const f32x2v t01 = {o.t.x, o.t.y}, t23 = {o.t.z, o.t.w}; \
        f32x2v d0 = S0a * a01; d0 = S0b * a23 + d0; f32x2v d1 = S1a * a01; d1 = S1b * a23 + d1; \
        float sa0 = d0.x + d0.y, sa1 = d1.x + d1.y; \
        if ((s) > 0) S_Y(op, YBc, (s) - 1); \
        const f32x2v u0a = S0a * w01 + t01 * o.v.x, u0b = S0b * w23 + t23 * o.v.x, u1a = S1a * w01 + t01 * o.v.y, u1b = S1b * w23 + t23 * o.v.y; \
        sa0 = row16_sum(sa0); sa1 = row16_sum(sa1); \
        S0a = b01 * sa0 + u0a; S0b = b23 * sa0 + u0b; S1a = b01 * sa1 + u1a; S1b = b23 * sa1 + u1b; } while (0)

    if (producer) { P_ISSUE(ldA, 0); P_STAGE(ldA, 0); P_ISSUE(ldB, 1); P_ISSUE(ldA, 2); }
    __syncthreads();
#define CHUNK(c, LDN) do { \
        if (producer) { P_YOUT((c) - 1); P_STAGE(LDN, (c) + 1); P_ISSUE(LDN, (c) + 3); \
            if (((c) & 7) == 0) { trw = ((c) >> 3) * tstride + trow0; if (trw < 32768) tab_issue(a, trw, lane_, trow); } \
            else if (((c) & 7) == 4) { if (trw < 32768) tab_finish(a, trw, lane_, trow); } \
            if (((c) & 15) == 2) { dcur = ((c) >> 4) * tstride + trow0; if (dcur < NDEF) { def_decode(a, dcur, dit); def_issue(dit, lane_, dtv); } } \
            else if (((c) & 15) == 10) { if (dcur < NDEF) def_finish(dit, dscr, lane_, dtv); } \
            else if (((c) & 15) == 5) { xrow = ((c) >> 4) * tstride + trow0; if (xrow < NREAL) { const f32x4v* xs_ = (const f32x4v*)(a.in[I_X] + (size_t)xrow * DM) + lane_; \
                    _Pragma("unroll") for (int j_ = 0; j_ < 8; ++j_) trow.x[j_] = xs_[64 * j_]; } } \
            else if (((c) & 15) == 7) { if (xrow < NREAL) { v2u* xd_ = (v2u*)((unsigned char*)a.out + XB_OFF + (size_t)xrow * DM * 2) + lane_; \
                    _Pragma("unroll") for (int j_ = 0; j_ < 8; ++j_) xd_[64 * j_] = (v2u){pk2(trow.x[j_].x, trow.x[j_].y), pk2(trow.x[j_].z, trow.x[j_].w)}; } } } \
        else { const LAS unsigned char* Bc = L + ((c) & 1) * BUF_BYTES; LAS unsigned char* YBc = L + OFF_Y + ((c) & 1) * YB_BYTES; \
            SOps o0, o1, o2, o3; S_LOAD(o0, Bc, 0); S_LOAD(o1, Bc, 1); \
            _Pragma("unroll") for (int s = 0; s < TC; s += 4) { \
                S_LOAD(o2, Bc, s + 2); S_STEP(o0, o3, YBc, s); S_LOAD(o3, Bc, s + 3); S_STEP(o1, o0, YBc, s + 1); \
                if (s + 4 < TC) S_LOAD(o0, Bc, s + 4); S_STEP(o2, o1, YBc, s + 2); if (s + 5 < TC) S_LOAD(o1, Bc, s + 5); S_STEP(o3, o2, YBc, s + 3); } \
            S_Y(o3, YBc, TC - 1); } \
        __syncthreads(); } while (0)
#pragma unroll 1
    for (int c = 0; c + 1 < NC; c += 2) { CHUNK(c, ldB); CHUNK(c + 1, ldA); }
    CHUNK(NC - 1, ldB);
#undef CHUNK
    if (producer) { P_YOUT(NC - 1); }
    __syncthreads();
#undef tok_row
#undef P_ISSUE
#undef P_STAGE
#undef P_YOUT
#undef S_LOAD
#undef S_STEP
#undef S_Y
}
}

__device__ __forceinline__ void p6_rwkv_finalize(const Args& a, const Ctx& C) {
    unsigned char* ws = a.ws;
    const bf16* RKV = (const bf16*)(ws + WS_RKV); const bf16* OMIC = (const bf16*)(ws + WS_OMIC); const bf16* Y = (const bf16*)(ws + WS_Y); bf16* G = (bf16*)(ws + WS_G);
    const int c0 = C.lane * 16;
    float ka[16], rk[16], lg[16], lb[16];
#pragma unroll
    for (int e = 0; e < 16; ++e) { ka[e] = a.in[I_KA][c0 + e]; rk[e] = a.in[I_RK][c0 + e]; lg[e] = a.in[I_LNG][c0 + e]; lb[e] = a.in[I_LNB][c0 + e]; }
    for (int rr = C.gw; rr < NREAL; rr += C.NGW) {
        const int m = (rr / SEQ) * LTOK + NMETA + (rr % SEQ);
        bf16* gp = G + (size_t)rr * 1024 + c0;
        float y[16], r[16], k[16], v[16], icm[16], g[16];
#define LD16(dst, ptr) do { const v4u t0_ = *(const v4u*)(ptr), t1_ = *(const v4u*)((ptr) + 8); \
        dst[0] = bf_lo(t0_.x); dst[1] = bf_hi(t0_.x); dst[2] = bf_lo(t0_.y); dst[3] = bf_hi(t0_.y); dst[4] = bf_lo(t0_.z); dst[5] = bf_hi(t0_.z); dst[6] = bf_lo(t0_.w); dst[7] = bf_hi(t0_.w); \
        dst[8] = bf_lo(t1_.x); dst[9] = bf_hi(t1_.x); dst[10] = bf_lo(t1_.y); dst[11] = bf_hi(t1_.y); dst[12] = bf_lo(t1_.z); dst[13] = bf_hi(t1_.z); dst[14] = bf_lo(t1_.w); dst[15] = bf_hi(t1_.w); } while (0)
        { float yb[16]; LD16(y, Y + (size_t)m * 1024 + c0); LD16(yb, Y + (size_t)TP * 1024 + (size_t)m * 1024 + c0);
#pragma unroll
          for (int e = 0; e < 16; ++e) y[e] += yb[e]; }
        { float ib[16]; LD16(icm, OMIC + (size_t)2 * TP * 1024 + (size_t)m * 1024 + c0); LD16(ib, OMIC + (size_t)3 * TP * 1024 + (size_t)m * 1024 + c0);
#pragma unroll
          for (int e = 0; e < 16; ++e) icm[e] = 0.5f * (icm[e] + ib[e]); }
        LD16(r, RKV + (size_t)m * 3072 + c0); LD16(k, RKV + (size_t)m * 3072 + 1024 + c0); LD16(v, RKV + (size_t)m * 3072 + 2048 + c0); LD16(g, gp);
#undef LD16
        float s1 = 0.f, bn = 0.f;
#pragma unroll
        for (int e = 0; e < 16; ++e) { s1 += y[e]; bn += r[e] * (k[e] * (1.0f + (icm[e] - 1.0f) * ka[e])) * rk[e]; }
        s1 += __shfl_xor(s1, 1); s1 += __shfl_xor(s1, 2); bn += __shfl_xor(bn, 1); bn += __shfl_xor(bn, 2);
        const float mu = s1 * (1.0f / 64.0f); float s2 = 0.f;
#pragma unroll
        for (int e = 0; e < 16; ++e) { y[e] -= mu; s2 += y[e] * y[e]; }
        s2 += __shfl_xor(s2, 1); s2 += __shfl_xor(s2, 2);
        const float rstd = 1.0f / sqrtf(s2 * (1.0f / 64.0f) + 64e-5f);
        float o[16];
#pragma unroll
        for (int e = 0; e < 16; ++e) o[e] = (y[e] * rstd * lg[e] + lb[e] + bn * v[e]) * g[e];
        v4u w8;
        w8.x = pk4_f8(o[0] * F8S_Y, o[1] * F8S_Y, o[2] * F8S_Y, o[3] * F8S_Y); w8.y = pk4_f8(o[4] * F8S_Y, o[5] * F8S_Y, o[6] * F8S_Y, o[7] * F8S_Y);
        w8.z = pk4_f8(o[8] * F8S_Y, o[9] * F8S_Y, o[10] * F8S_Y, o[11] * F8S_Y); w8.w = pk4_f8(o[12] * F8S_Y, o[13] * F8S_Y, o[14] * F8S_Y, o[15] * F8S_Y);
        *(v4u*)(ws + WS_YR8 + (size_t)rr * 1024 + c0) = w8;
    }
}

constexpr int NEXP = 16384;
constexpr size_t WS_EXPG = 138 * MiB;

__device__ __forceinline__ void p9_norm_tables(const Args& a, const Ctx& C) {
    unsigned char* ws = a.ws;
    const bf16* H1 = (const bf16*)(ws + WS_H1); bf16* N2 = (bf16*)(ws + WS_N2);
    const float* g = a.in[I_NFG];
    constexpr int RB = 2;
    for (int m0 = C.gw; m0 < NREAL; m0 += RB * C.NGW) {
        v2u t[RB][8];
#pragma unroll
        for (int i = 0; i < RB; ++i) { const int m = m0 + i * C.NGW; if (m < NREAL) { const v2u* xr = (const v2u*)(H1 + (size_t)m * DM) + C.lane;
#pragma unroll
            for (int j = 0; j < 8; ++j) t[i][j] = xr[64 * j]; } }
#pragma unroll
        for (int i = 0; i < RB; ++i) { const int m = m0 + i * C.NGW; if (m < NREAL) {
            unsigned long long* o8 = (unsigned long long*)(N2 + (size_t)m * DM) + C.lane; const f32x4v* gr = (const f32x4v*)g + C.lane;
            f32x4v v[8]; float s = 0.f;
#pragma unroll
            for (int j = 0; j < 8; ++j) { v[j] = (f32x4v){bf_lo(t[i][j].x), bf_hi(t[i][j].x), bf_lo(t[i][j].y), bf_hi(t[i][j].y)}; s += (v[j].x * v[j].x + v[j].y * v[j].y) + (v[j].z * v[j].z + v[j].w * v[j].w); }
            const float rstd = 1.0f / sqrtf(wave_sum(s) * (1.f / DM) + NORM_EPS);
#pragma unroll
            for (int j = 0; j < 8; ++j) { const f32x4v gg = gr[64 * j];
                o8[64 * j] = (unsigned long long)pk2(v[j].x * rstd * gg.x, v[j].y * rstd * gg.y) | ((unsigned long long)pk2(v[j].z * rstd * gg.z, v[j].w * rstd * gg.w) << 32); } } }
    }
}

__device__ __forceinline__ unsigned fkey(float f) { const unsigned u = __float_as_uint(f); return (u & 0x80000000u) ? ~u : (u | 0x80000000u); }
__device__ __forceinline__ float fkey_inv(unsigned k) { const unsigned u = (k & 0x80000000u) ? (k ^ 0x80000000u) : ~k; return __uint_as_float(u); }

__device__ __forceinline__ void bitonic16_desc(unsigned (&c)[16]) {
#pragma unroll
    for (int j = 8; j > 0; j >>= 1)
#pragma unroll
        for (int i = 0; i < 16; ++i) { const int l = i ^ j; if (l > i) { const unsigned hi = c[i] > c[l] ? c[i] : c[l], lo = c[i] > c[l] ? c[l] : c[i]; c[i] = hi; c[l] = lo; } }
}
__device__ __forceinline__ void sort16_desc(unsigned (&c)[16]) {
#pragma unroll
    for (int k = 2; k <= 16; k <<= 1)
#pragma unroll
        for (int j = k >> 1; j > 0; j >>= 1)
#pragma unroll
            for (int i = 0; i < 16; ++i) { const int l = i ^ j;
                if (l > i) { const unsigned hi = c[i] > c[l] ? c[i] : c[l], lo = c[i] > c[l] ? c[l] : c[i]; const bool desc = ((i & k) == 0); c[i] = desc ? hi : lo; c[l] = desc ? lo : hi; } }
}
__device__ __forceinline__ float h2f_(unsigned short h) { return (float)__builtin_bit_cast(_Float16, h); }
__device__ __forceinline__ void p10b_select(const Args& a, const Ctx& C) {
    unsigned char* ws = a.ws;
    const unsigned short* SC = (const unsigned short*)(ws + WS_SC);
    unsigned long long* EXPG = (unsigned long long*)(ws + WS_EXPG);
    LAS unsigned* keys = (LAS unsigned*)C.lds;
    for (int blk = blockIdx.x; blk < NREAL / 32; blk += C.G) {
        {
            const unsigned short* sblk = SC + (size_t)blk * 32 * DM;
            LAS unsigned char* stg = C.lds + 512 * 16 * 4;
            unsigned v[16];
            v4u gl[8];
#define P10_FETCH(ln_) do { _Pragma("unroll") for (int j = 0; j < 8; ++j) { const int P = C.tid + 512 * j, L = P >> 3, cc = P & 7; \
                gl[j] = *(const v4u*)(sblk + (size_t)(L >> 4) * DM + (L & 15) * 128 + (ln_) * 64 + cc * 8); } } while (0)
            P10_FETCH(0);
#pragma unroll 1
            for (int ln = 0; ln < 2; ++ln) {
                __syncthreads();
#pragma unroll
                for (int j = 0; j < 8; ++j) { const int P = C.tid + 512 * j, L = P >> 3, cc = P & 7; *(LAS v4u*)(stg + L * 144 + cc * 16) = gl[j]; }
                __syncthreads();
                if (ln < 1) P10_FETCH(ln + 1);
                v4u xb[8];
#pragma unroll
                for (int q = 0; q < 8; ++q) xb[q] = *(const LAS v4u*)(stg + C.tid * 144 + q * 16);
#pragma unroll
                for (int hc = 0; hc < 4; ++hc) {
                    unsigned c[16];
#pragma unroll
                    for (int q = 0; q < 2; ++q)
#pragma unroll
                        for (int e = 0; e < 4; ++e) { const unsigned w = xb[2 * hc + q][e]; const int k0 = 64 * ln + 16 * hc + 8 * q + 2 * e;
                            c[8 * q + 2 * e] = (fkey(h2f_((unsigned short)(w & 0xffffu))) & ~0x7fu) | (unsigned)(127 - k0);
                            c[8 * q + 2 * e + 1] = (fkey(h2f_((unsigned short)(w >> 16))) & ~0x7fu) | (unsigned)(127 - (k0 + 1)); }
                    sort16_desc(c);
                    if (ln == 0 && hc == 0) {
#pragma unroll
                        for (int k = 0; k < 16; ++k) v[k] = c[k];
                    } else {
#pragma unroll
                        for (int k = 0; k < 16; ++k) v[k] = v[k] > c[15 - k] ? v[k] : c[15 - k];
                        bitonic16_desc(v);
                    }
                }
            }
#undef P10_FETCH
#pragma unroll
            for (int k = 0; k < 16; k += 4) *(LAS v4u*)(keys + C.tid * 16 + k) = (v4u){v[k], v[k + 1], v[k + 2], v[k + 3]};
        }
        __syncthreads();
        if (C.tid < 256) {
            const int tl = C.tid >> 3, hh = C.tid & 7, r = blk * 32 + tl;
            const LAS unsigned* ka = keys + (tl * 16 + 2 * hh) * 16; const LAS unsigned* kb = ka + 16;
            const float rs_ = ((const float*)(ws + WS_RSTD))[r];
            float af[16], bf_[16];
#pragma unroll
            for (int k = 0; k < 16; ++k) { af[k] = fkey_inv((ka[k] & ~0x7fu) | 0x40u) * rs_; bf_[k] = fkey_inv((kb[k] & ~0x7fu) | 0x40u) * rs_; }
            unsigned w[16];
#pragma unroll
            for (int k = 0; k < 16; ++k) w[k] = 0u;
#pragma unroll
            for (int i = 0; i < 16; ++i)
#pragma unroll
                for (int j = 0; j < 16; ++j)
                    if ((i + 1) * (j + 1) <= 16) {
                        unsigned x = (fkey(af[i] + bf_[j]) & ~0xffu) | (unsigned)(255 - (i * 16 + j));
#pragma unroll
                        for (int k = 0; k < 16; ++k) { const unsigned t = w[k] > x ? w[k] : x; x = w[k] > x ? x : w[k]; w[k] = t; }
                    }
            float sv[16]; const float mx = fkey_inv((w[0] & ~0xffu) | 0x80u); float z = 0.f;
#pragma unroll
            for (int k = 0; k < 16; ++k) { sv[k] = __expf(fkey_inv((w[k] & ~0xffu) | 0x80u) - mx); z += sv[k]; }
            const float rz = 1.0f / z;
            unsigned long long* out = EXPG + (size_t)r * 128 + hh * 16;
#pragma unroll
            for (int k = 0; k < 16; ++k) { const int c = 255 - (int)(w[k] & 0xffu); const int i1 = 127 - (int)(ka[c >> 4] & 0x7fu), i2 = 127 - (int)(kb[c & 15] & 0x7fu);
                out[k] = (unsigned long long)(unsigned)(i1 * 128 + i2) | ((unsigned long long)__float_as_uint(sv[k] * rz) << 32); }
        }
        __syncthreads();
    }
}

__device__ __forceinline__ float gelu_erf(float v) {
    const float av = fabsf(v), t = __builtin_amdgcn_rcpf(av * 0.2316418882f + 1.0f);
    float q = t * 0.5307027145f + (-0.7265760135f); q = q * t + 0.7107068705f; q = q * t + (-0.142248368f); q = q * t + 0.127414796f; q = q * t;
    const float e = __builtin_amdgcn_exp2f((v * v) * (-0.72134752044f));
    const float m = v * (q * e);
    return v < 0.f ? m : v - m;
}

typedef float f32x2w __attribute__((ext_vector_type(2)));
__device__ __forceinline__ float wave_total(float x) {
    x = scan::row16_sum(x);
    const int xi = __float_as_int(x);
    return (__int_as_float(__builtin_amdgcn_readlane(xi, 0)) + __int_as_float(__builtin_amdgcn_readlane(xi, 16))) + (__int_as_float(__builtin_amdgcn_readlane(xi, 32)) + __int_as_float(__builtin_amdgcn_readlane(xi, 48)));
}
typedef _Float16 h2t __attribute__((ext_vector_type(2)));
__device__ __forceinline__ void p11_peer_out(const Args& a, const Ctx& C) {
    unsigned char* ws = a.ws;
    const bf16* H1 = (const bf16*)(ws + WS_H1); const bf16* N2 = (const bf16*)(ws + WS_N2);
    const unsigned char* U = ws + WS_UQ; const unsigned char* V = ws + WS_VQ;
    const unsigned long long* EXPG = (const unsigned long long*)(ws + WS_EXPG);
    constexpr int PT = 4;
    LAS unsigned long long* egw = (LAS unsigned long long*)(C.lds) + C.wave * (PT * 128);
    LAS float* cw = (LAS float*)(C.lds + NWAVES * PT * 128 * 8) + C.wave * (PT * 128);
    const float* fg = a.in[I_FNG];
#define FP4H(w, b) __builtin_amdgcn_cvt_scalef32_pk_f16_fp4((w), 1.0f, (b))
#define PE_ISSUE(T, RR, SS, t_, q0) do { if (rbase + (t_) * C.NGW < NREAL) { _Pragma("unroll") for (int x_ = 0; x_ < 8; ++x_) { \
            const unsigned e_ = (unsigned)__builtin_amdgcn_readfirstlane((int)(unsigned)egw[(t_) * 128 + (q0) + x_]); const unsigned char* p_ = (T) + (size_t)e_ * TROW; \
            RR[x_] = *(const v4u*)(p_ + C.lane * 16); SS[x_] = *(const unsigned short*)(p_ + 1024 + C.lane * 2); } } } while (0)
#define PE_SW32(x, y) ({ auto r_ = __builtin_amdgcn_permlane32_swap(__float_as_uint(x), __float_as_uint(y), false, false); __uint_as_float(r_[0]) + __uint_as_float(r_[1]); })
#define PE_SW16(x, y) ({ auto r_ = __builtin_amdgcn_permlane16_swap(__float_as_uint(x), __float_as_uint(y), false, false); __uint_as_float(r_[0]) + __uint_as_float(r_[1]); })
    const int pe_row = C.lane >> 4, pe_idx = (pe_row >> 1) + 2 * (pe_row & 1) + 4 * ((C.lane >> 3) & 1);
    for (int rbase = C.gw; rbase < NREAL; rbase += PT * C.NGW) {
        h2t st[PT][16];
#pragma unroll
        for (int t = 0; t < PT; ++t) { const int r = rbase + t * C.NGW; if (r < NREAL) {
            LAS unsigned long long* eg = egw + t * 128;
            const unsigned long long pa = EXPG[(size_t)r * 128 + C.lane], pb = EXPG[(size_t)r * 128 + 64 + C.lane];
            const unsigned ba = ((unsigned)pa >> 10) & 15u, bbk = ((unsigned)pb >> 10) & 15u;
            unsigned base = 0u, posa = 0u, posb = 0u;
#pragma unroll
            for (unsigned q = 0; q < 16; ++q) { const unsigned long long ma = __ballot(ba == q), mb = __ballot(bbk == q);
                const unsigned ca = __builtin_amdgcn_mbcnt_hi((unsigned)(ma >> 32), __builtin_amdgcn_mbcnt_lo((unsigned)ma, 0u)), cb = __builtin_amdgcn_mbcnt_hi((unsigned)(mb >> 32), __builtin_amdgcn_mbcnt_lo((unsigned)mb, 0u));
                const unsigned na = (unsigned)__popcll(ma);
                if (ba == q) posa = base + ca; if (bbk == q) posb = base + na + cb;
                base += na + (unsigned)__popcll(mb); }
            eg[posa] = pa; eg[posb] = pb;
            const float rs = ((const float*)(ws + WS_RSTD))[r];
#pragma unroll
            for (int m = 0; m < 4; ++m) { const v2u t0 = *(const v2u*)(N2 + (size_t)r * DM + 512 * m + C.lane * 4), t1 = *(const v2u*)(N2 + (size_t)r * DM + 512 * m + 256 + C.lane * 4);
                st[t][4 * m + 0] = __builtin_bit_cast(h2t, __builtin_amdgcn_cvt_pkrtz(bf_lo(t0.x) * rs, bf_lo(t1.x) * rs)); st[t][4 * m + 1] = __builtin_bit_cast(h2t, __builtin_amdgcn_cvt_pkrtz(bf_hi(t0.x) * rs, bf_hi(t1.x) * rs));
                st[t][4 * m + 2] = __builtin_bit_cast(h2t, __builtin_amdgcn_cvt_pkrtz(bf_lo(t0.y) * rs, bf_lo(t1.y) * rs)); st[t][4 * m + 3] = __builtin_bit_cast(h2t, __builtin_amdgcn_cvt_pkrtz(bf_hi(t0.y) * rs, bf_hi(t1.y) * rs)); } } }
        LDS_WAIT();
        v4u ra[8], rbv[8]; unsigned short sa[8], sb[8];
#define PE_UROUND(t_, RR, SS, q0) do { if (rbase + (t_) * C.NGW < NREAL) { float zs[8]; _Pragma("unroll") for (int x_ = 0; x_ < 8; ++x_) { float d0_ = 0.f, d1_ = 0.f; \
                _Pragma("unroll") for (int m = 0; m < 4; m += 2) { \
                    d0_ = __builtin_amdgcn_fdot2(FP4H(RR[x_][m], 0), st[t_][4 * m + 0], d0_, false); d1_ = __builtin_amdgcn_fdot2(FP4H(RR[x_][m + 1], 0), st[t_][4 * (m + 1) + 0], d1_, false); \
                    d0_ = __builtin_amdgcn_fdot2(FP4H(RR[x_][m], 1), st[t_][4 * m + 1], d0_, false); d1_ = __builtin_amdgcn_fdot2(FP4H(RR[x_][m + 1], 1), st[t_][4 * (m + 1) + 1], d1_, false); \
                    d0_ = __builtin_amdgcn_fdot2(FP4H(RR[x_][m], 2), st[t_][4 * m + 2], d0_, false); d1_ = __builtin_amdgcn_fdot2(FP4H(RR[x_][m + 1], 2), st[t_][4 * (m + 1) + 2], d1_, false); \
                    d0_ = __builtin_amdgcn_fdot2(FP4H(RR[x_][m], 3), st[t_][4 * m + 3], d0_, false); d1_ = __builtin_amdgcn_fdot2(FP4H(RR[x_][m + 1], 3), st[t_][4 * (m + 1) + 3], d1_, false); } \
                zs[x_] = (d0_ + d1_) * bf2f(SS[x_]); } \
            const float t0_ = scan::row16_sum(PE_SW16(PE_SW32(zs[0], zs[1]), PE_SW32(zs[2], zs[3]))); \
            const float t1_ = scan::row16_sum(PE_SW16(PE_SW32(zs[4], zs[5]), PE_SW32(zs[6], zs[7]))); \
            const float cv_ = gelu_erf((C.lane & 8) ? t1_ : t0_) * __uint_as_float(((const LAS unsigned*)(egw + (t_) * 128))[2 * ((q0) + pe_idx) + 1]); \
            if ((C.lane & 7) == 0) cw[(t_) * 128 + (q0) + pe_idx] = cv_; } } while (0)
        PE_ISSUE(U, ra, sa, 0, 0); PE_ISSUE(U, rbv, sb, 1, 0);
#pragma unroll 1
        for (int q = 0; q < 128; q += 8) {
#pragma unroll
            for (int t = 0; t < PT; t += 2) {
                PE_UROUND(t, ra, sa, q);     if (t + 2 < PT) PE_ISSUE(U, ra, sa, t + 2, q);  else if (q + 8 < 128) PE_ISSUE(U, ra, sa, 0, q + 8);
                PE_UROUND(t + 1, rbv, sb, q); if (t + 3 < PT) PE_ISSUE(U, rbv, sb, t + 3, q); else if (q + 8 < 128) PE_ISSUE(U, rbv, sb, 1, q + 8);
            }
        }
#undef PE_UROUND
        LDS_WAIT();
#pragma unroll
        for (int t = 0; t < PT; ++t)
#pragma unroll
            for (int p = 0; p < 16; ++p) st[t][p] = (h2t){(_Float16)0.f, (_Float16)0.f};
#define PE_VROUND(t_, RR, SS, q0) do { if (rbase + (t_) * C.NGW < NREAL) { const f32x4v ca_ = *(const LAS f32x4v*)(cw + (t_) * 128 + (q0)), cb_ = *(const LAS f32x4v*)(cw + (t_) * 128 + (q0) + 4); \
            _Pragma("unroll") for (int x_ = 0; x_ < 8; ++x_) { const float c_ = (x_ < 4 ? ca_[x_ & 3] : cb_[x_ & 3]) * bf2f(SS[x_]); const h2t ch_ = __builtin_bit_cast(h2t, __builtin_amdgcn_cvt_pkrtz(c_, c_)); \
                _Pragma("unroll") for (int m = 0; m < 4; ++m) { st[t_][4 * m + 0] = FP4H(RR[x_][m], 0) * ch_ + st[t_][4 * m + 0]; st[t_][4 * m + 1] = FP4H(RR[x_][m], 1) * ch_ + st[t_][4 * m + 1]; \
                    st[t_][4 * m + 2] = FP4H(RR[x_][m], 2) * ch_ + st[t_][4 * m + 2]; st[t_][4 * m + 3] = FP4H(RR[x_][m], 3) * ch_ + st[t_][4 * m + 3]; } } } } while (0)
        PE_ISSUE(V, ra, sa, 0, 0); PE_ISSUE(V, rbv, sb, 1, 0);
#pragma unroll 1
        for (int q = 0; q < 128; q += 8) {
#pragma unroll
            for (int t = 0; t < PT; t += 2) {
                PE_VROUND(t, ra, sa, q);     if (t + 2 < PT) PE_ISSUE(V, ra, sa, t + 2, q);  else if (q + 8 < 128) PE_ISSUE(V, ra, sa, 0, q + 8);
                PE_VROUND(t + 1, rbv, sb, q); if (t + 3 < PT) PE_ISSUE(V, rbv, sb, t + 3, q); else if (q + 8 < 128) PE_ISSUE(V, rbv, sb, 1, q + 8);
            }
        }
#undef PE_VROUND
#pragma unroll
        for (int t = 0; t < PT; ++t) { const int r = rbase + t * C.NGW; if (r < NREAL) {
            f32x2w acc[4][4]; float s = 0.f;
#pragma unroll
            for (int m = 0; m < 4; ++m) { const v2u t0 = *(const v2u*)(N2 + (size_t)r * DM + 512 * m + C.lane * 4), t1 = *(const v2u*)(N2 + (size_t)r * DM + 512 * m + 256 + C.lane * 4);
                const f32x4v q0 = *(const f32x4v*)(a.in[I_NFG] + 512 * m + C.lane * 4), q1 = *(const f32x4v*)(a.in[I_NFG] + 512 * m + 256 + C.lane * 4);
#define RC_(v) __builtin_amdgcn_rcpf(v)
                const f32x4v x0 = {bf_lo(t0.x) * RC_(q0.x), bf_hi(t0.x) * RC_(q0.y), bf_lo(t0.y) * RC_(q0.z), bf_hi(t0.y) * RC_(q0.w)}, x1 = {bf_lo(t1.x) * RC_(q1.x), bf_hi(t1.x) * RC_(q1.y), bf_lo(t1.y) * RC_(q1.z), bf_hi(t1.y) * RC_(q1.w)};
#undef RC_
#pragma unroll
                for (int i = 0; i < 4; ++i) { acc[m][i].x = (float)st[t][4 * m + i][0] + x0[i]; acc[m][i].y = (float)st[t][4 * m + i][1] + x1[i]; s += acc[m][i].x * acc[m][i].x + acc[m][i].y * acc[m][i].y; } }
            const float rstd = 1.0f / sqrtf(wave_sum(s) * (1.f / DM) + NORM_EPS);
#pragma unroll
            for (int m = 0; m < 4; ++m) { const int e0 = 512 * m + C.lane * 4; const f32x4v g0 = *(const f32x4v*)(fg + e0), g1 = *(const f32x4v*)(fg + e0 + 256);
                *(f32x4v*)(a.out + (size_t)r * DM + e0) = (f32x4v){acc[m][0].x * rstd * g0.x, acc[m][1].x * rstd * g0.y, acc[m][2].x * rstd * g0.z, acc[m][3].x * rstd * g0.w};
                *(f32x4v*)(a.out + (size_t)r * DM + e0 + 256) = (f32x4v){acc[m][0].y * rstd * g1.x, acc[m][1].y * rstd * g1.y, acc[m][2].y * rstd * g1.z, acc[m][3].y * rstd * g1.w}; } } }
        LDS_WAIT();
    }
#undef PE_ISSUE
#undef PE_SW32
#undef PE_SW16
#undef FP4H
}
#define XB_TMO      128
#define XB_XCNT(j)  (256  + 64 * (j))
#define XB_XSUB(j)  (1280 + 64 * (j))
#define XB_XGEN(j)  (2304 + 64 * (j))
#define XB_TOP      3328
#define XB_TOPGEN   3392
#define XCD_BAR_WORDS 3456
#define XB_SPIN_CAP (1u << 23)

__device__ __forceinline__ unsigned xb_ld(unsigned* p)              { return __hip_atomic_load(p, __ATOMIC_RELAXED, __HIP_MEMORY_SCOPE_AGENT); }
__device__ __forceinline__ unsigned xb_add(unsigned* p, unsigned v) { return __hip_atomic_fetch_add(p, v, __ATOMIC_RELAXED, __HIP_MEMORY_SCOPE_AGENT); }
__device__ __forceinline__ unsigned xb_xcc_id() { return (unsigned)__builtin_amdgcn_s_getreg((3 << 11) | 20) & 0xFu; }
#define XB_SPIN(cond, bar) do { unsigned _sp = 0; while (cond) { __builtin_amdgcn_s_sleep(1); \
    if ((++_sp & 255u) == 0u) { if (xb_ld(&(bar)[XB_TMO])) break; if (_sp > XB_SPIN_CAP) { atomicAdd(&(bar)[XB_TMO], 1u); break; } } } } while (0)

struct XcdBarrier {
    unsigned* bar; unsigned x;
    volatile LAS unsigned* st;
};

__device__ __forceinline__ XcdBarrier xcd_barrier_post(unsigned* bar, volatile LAS unsigned* st) {
    XcdBarrier b; b.bar = bar; b.x = xb_xcc_id(); b.st = st;
    if (threadIdx.x == 0) (void)xb_add(&bar[XB_XCNT(b.x)], 1u);
    return b;
}
__device__ __forceinline__ void xcd_barrier_complete(unsigned* bar, unsigned x, unsigned& nloc, unsigned& nx) {
    const unsigned G = gridDim.x * gridDim.y * gridDim.z;
    unsigned sum, cnt, mine, sp = 0u;
    for (;;) {
        sum = 0u; cnt = 0u; mine = 0u;
#pragma unroll
        for (unsigned j = 0; j < 16; ++j) { const unsigned c = xb_ld(&bar[XB_XCNT(j)]); sum += c; cnt += (c > 0u) ? 1u : 0u; mine = (j == x) ? c : mine; }
        if (sum == G) break;
        __builtin_amdgcn_s_sleep(1);
        if ((++sp & 255u) == 0u) { if (xb_ld(&bar[XB_TMO])) break; if (sp > XB_SPIN_CAP) { atomicAdd(&bar[XB_TMO], 1u); break; } }
    }
    nloc = mine > 0u ? mine : 1u; nx = cnt > 0u ? cnt : 1u;
}

__device__ __forceinline__ void xcd_barrier(const XcdBarrier& b) {
    asm volatile("s_waitcnt vmcnt(0)" ::: "memory");
    __syncthreads();
    if (threadIdx.x == 0) {
        unsigned* bar = b.bar;
        __builtin_amdgcn_s_waitcnt(0);
        unsigned nloc = b.st[0], nx = b.st[1];
        if (nloc == 0u) { xcd_barrier_complete(bar, b.x, nloc, nx); b.st[0] = nloc; b.st[1] = nx; }
        const unsigned old = xb_add(&bar[XB_XSUB(b.x)], 1u);
        const unsigned gen = old / nloc;
        if (old + 1u == (gen + 1u) * nloc) {
            __builtin_amdgcn_fence(__ATOMIC_RELEASE, "agent");
            asm volatile("s_waitcnt vmcnt(0)" ::: "memory");
            const unsigned og = xb_add(&bar[XB_TOP], 1u);
            const unsigned tg = og / nx;
            if (og + 1u == (tg + 1u) * nx) xb_add(&bar[XB_TOPGEN], 1u);
            else XB_SPIN(xb_ld(&bar[XB_TOPGEN]) == tg, bar);
            __builtin_amdgcn_fence(__ATOMIC_ACQUIRE, "agent");
            xb_add(&bar[XB_XGEN(b.x)], 1u);
            asm volatile("s_waitcnt vmcnt(0)" ::: "memory");
        } else {
            XB_SPIN(xb_ld(&bar[XB_XGEN(b.x)]) == gen, bar);
            __builtin_amdgcn_fence(__ATOMIC_ACQUIRE, "agent");
            asm volatile("s_waitcnt vmcnt(0)" ::: "memory");
        }
    }
    __syncthreads();
}

constexpr int LDS_BYTES = 147456;
template <class F> __device__ __forceinline__ void run_gemm(LAS unsigned char* lds, const bf16* A, const bf16* Bt, int M, int N, int K, int G, const F& f) {
    pg8::Gemm g{A, Bt, M, N, K}; pg8::StaticOrder S; S.init(M, N, G, (int)blockIdx.x);
    epi::EpiG<F> E{f};
    pg8::gemm_phase<epi::EpiG<F>, pg8::StaticOrder, true, true>(lds, g, S, E);
}

template <class F> __device__ __forceinline__ void run_gemm8(LAS unsigned char* lds, const void* A8, const void* Bt8, int M, int N, int K, int G, const F& f) {
    pg8::Gemm g{(const bf16*)A8, (const bf16*)Bt8, M, N, K / 2}; pg8::StaticOrder S; S.init(M, N, G, (int)blockIdx.x);
    epi::EpiG<F> E{f};
    pg8::gemm_phase<epi::EpiG<F>, pg8::StaticOrder, true, true, true>(lds, g, S, E);
}

__global__ void __launch_bounds__(NWAVES * 64, 2) mega_fwd(Args a) {
    extern __shared__ __attribute__((aligned(16))) unsigned char lds_raw[];
    cg::grid_group grid = cg::this_grid();
    Ctx C;
    C.lds = (LAS unsigned char*)lds_raw;
    C.tid = threadIdx.x; C.lane = C.tid & 63; C.wave = __builtin_amdgcn_readfirstlane(C.tid >> 6);
    C.G = gridDim.x; { const int bx = blockIdx.x; C.vcu = (C.G % 8 == 0) ? (bx % 8) * (C.G / 8) + bx / 8 : bx; }
    C.gw = blockIdx.x * NWAVES + C.wave; C.NGW = C.G * NWAVES;
    unsigned char* ws = a.ws;
    volatile LAS unsigned* MISC = (volatile LAS unsigned*)(C.lds + LDS_BYTES - 64);
    if (C.tid < 16) MISC[C.tid] = 0u;
    __syncthreads();
    if (blockIdx.x == 0) { unsigned* bw_ = (unsigned*)(ws + WS_CTL);
        for (int i = threadIdx.x; i < 4096; i += NWAVES * 64) __hip_atomic_store(bw_ + i, 0u, __ATOMIC_RELAXED, __HIP_MEMORY_SCOPE_AGENT); }
#define REFRESH() do { int t_ = threadIdx.x; asm volatile("" : "+v"(t_)); C.tid = t_; C.lane = t_ & 63; } while (0)
#define GSYNC() do { xcd_barrier(xbar); REFRESH(); } while (0)

    p0_prologue(a, C);
    grid.sync(); REFRESH();
    XcdBarrier xbar = xcd_barrier_post((unsigned*)(ws + WS_CTL), MISC);
    run_gemm(C.lds, (const bf16*)(ws + WS_XN), (const bf16*)(ws + WS_WIN), TP, NPROJ_A, DM, C.G, epi::FStoreBf16{(bf16*)(ws + WS_PROJ) + 1024, NPROJ});
    { const int extra = ((TP / 256) * (NPROJ_A / 256)) % C.G, skip = (2 * extra < C.G) ? extra : 0;
      pg8::Gemm g{(const bf16*)(ws + WS_XN8T), (const bf16*)(ws + WS_WIN8), TP, NPROJ_B, DM / 2}; pg8::StaticOrder S; S.init(TP, NPROJ_B, C.G - skip, (int)blockIdx.x - skip);
      epi::EpiG<epi::FStoreProjB> E{epi::FStoreProjB{(bf16*)(ws + WS_PROJ), NPROJ, 1.0f / (F8S_XN * F8S_W)}};
      pg8::gemm_phase<epi::EpiG<epi::FStoreProjB>, pg8::StaticOrder, true, true, true>(C.lds, g, S, E); }
    { pg8::Gemm g{(const bf16*)(ws + WS_AFULL), (const bf16*)(ws + WS_WQBF), DM, DM, 256, DM, 256}; pg8::StaticOrder S; S.init(DM, DM, C.G, (int)blockIdx.x);
      epi::EpiG<epi::FStoreBf16> E{epi::FStoreBf16{(bf16*)(ws + WS_WSCORE), DM}};
      pg8::gemm_phase<epi::EpiG<epi::FStoreBf16>, pg8::StaticOrder, true, true>(C.lds, g, S, E); }
    GSYNC();
    p2_mla_prep(a, C);
    p2_rwkv_prep(a, C);
    GSYNC();
    run_gemm(C.lds, (const bf16*)(ws + WS_AW), (const bf16*)(ws + WS_WLW), TP, 4096, 256, C.G, epi::FLoraW{(bf16*)(ws + WS_OMIC), a.in[I_W0], a.in[I_A0]});
    run_gemm(C.lds, (const bf16*)(ws + WS_AG), (const bf16*)(ws + WS_WLG), NREAL, 1024, 256, C.G, epi::FStoreBf16{(bf16*)(ws + WS_G), 1024});
    GSYNC();
    for (int it = blockIdx.x; it < 256; it += C.G) scan::scan_item(a, C, it);
    GSYNC();
    p6_rwkv_finalize(a, C);
    GSYNC();
    {
        const long gt = (long)C.gw * 64 + C.lane, NGT = (long)C.NGW * 64;
        for (long i = gt; i < (long)BATCH * MLA_H * 128 * 14; i += NGT) { const int bhd = (int)(i / 14), u = (int)(i - (long)bhd * 14), bh = bhd >> 7, d = bhd & 127;
            const int tile = u < 6 ? 64 : 65, unit = u < 6 ? (u < 3 ? u + 1 : u + 2) : u - 6;
            *(v2u*)(ws + WS_V + ((size_t)(bh * NTV + tile) * 128 + d) * 64 + unit * 8) = (v2u){0u, 0u}; }
    }
    run_gemm8(C.lds, ws + WS_QN, ws + WS_WUQ, NREAL, NQ, 512, C.G,
              epi::FQRope{ws + WS_Q, (const float*)(ws + WS_ROPE), (const float*)(ws + WS_ROPE + MiB)});
    run_gemm8(C.lds, ws + WS_KVN, ws + WS_WUKV, TP, NKV, 512, C.G, epi::FKVSplit{ws + WS_KV, ws + WS_V});
    GSYNC();
    {
        constexpr int NQB = SEQ / 256, NUNITS = BATCH * MLA_H * NQB;
        for (int u = C.vcu; u < NUNITS; u += C.G) {
            const int bh = u / NQB, qb = u - bh * NQB;
            att::attn_unit(bh / MLA_H, bh % MLA_H, qb * 256, ws + WS_Q, ws + WS_KV, ws + WS_V, ws + WS_KR, (bf16*)(ws + WS_O), (char*)lds_raw);
        }
    }
    GSYNC();
    run_gemm8(C.lds, a.out, ws + WS_WG, NREAL, DM, DM, C.G, epi::FGate8{ws + WS_BUF2, a.in[I_BGATE]});
    run_gemm8(C.lds, ws + WS_YR8, ws + WS_WPR, NREAL, DM, 1024, C.G, epi::FMulG8<0>{(bf16*)(ws + WS_BUF1), ws + WS_BUF2, nullptr, nullptr});
    run_gemm8(C.lds, a.out, ws + WS_WG + (size_t)DM * DM, NREAL, DM, DM, C.G, epi::FGate8{ws + WS_BUF2, a.in[I_BGATE] + DM});
    run_gemm8(C.lds, ws + WS_O, ws + WS_WPM, NREAL, DM, DM, C.G, epi::FMulG8<1>{nullptr, ws + WS_BUF2, (const bf16*)(ws + WS_BUF1), ws + WS_M8});
    GSYNC();
    { pg8::Gemm g{(const bf16*)(ws + WS_M8), (const bf16*)(ws + WS_WO), NREAL, DM, DM / 2}; pg8::StaticOrder S; S.init(NREAL, DM, C.G, (int)blockIdx.x);
      epi::EpiResidNorm E{(bf16*)(ws + WS_N2), (const bf16*)((const unsigned char*)a.out + XB_OFF), a.in[I_NFG], (float*)(ws + WS_SSQ), 1.0f / (F8S_M * F8S_W)};
      pg8::gemm_phase<epi::EpiResidNorm, pg8::StaticOrder, true, true, true>(C.lds, g, S, E); }
    GSYNC();
    { const float* SSQ = (const float*)(ws + WS_SSQ); float* RSTD = (float*)(ws + WS_RSTD);
      for (int r = C.gw * 64 + C.lane; r < NREAL; r += C.NGW * 64) { float s = 0.f;
#pragma unroll
          for (int j = 0; j < 8; ++j) { const f32x4v t = *(const f32x4v*)(SSQ + (size_t)r * 32 + 4 * j); s += (t.x + t.y) + (t.z + t.w); }
          RSTD[r] = 1.0f / sqrtf(s * (1.f / DM) + NORM_EPS); } }
    run_gemm(C.lds, (const bf16*)(ws + WS_N2), (const bf16*)(ws + WS_WSCORE), NREAL, DM, DM, C.G, epi::FStoreF16{(unsigned short*)(ws + WS_SC), DM});
    GSYNC();
    p10b_select(a, C);
    GSYNC();
    p11_peer_out(a, C);
}

extern "C" void kernel_launch(void* const* d_in, const int* in_sizes, int n_in, void* d_out, int out_size, void* d_ws, size_t ws_size, hipStream_t stream) {
    static int grid = 0;
    if (grid == 0) {
        int dev = 0, cus = 0, per_cu = 0;
        if (n_in != 29 || ws_size < WS_END) { fprintf(stderr, "kernel_launch: unexpected n_in %d / ws_size %zu (need %zu)\n", n_in, ws_size, (size_t)WS_END); grid = -1; return; }
        if (hipGetDevice(&dev) != hipSuccess || hipDeviceGetAttribute(&cus, hipDeviceAttributeMultiprocessorCount, dev) != hipSuccess) { grid = -1; return; }
        if (hipFuncSetAttribute((const void*)mega_fwd, hipFuncAttributeMaxDynamicSharedMemorySize, LDS_BYTES) != hipSuccess) { fprintf(stderr, "kernel_launch: hipFuncSetAttribute failed\n"); grid = -1; return; }
        if (hipOccupancyMaxActiveBlocksPerMultiprocessor(&per_cu, (const void*)mega_fwd, NWAVES * 64, LDS_BYTES) != hipSuccess || per_cu < 1) { fprintf(stderr, "kernel_launch: occupancy query says %d\n", per_cu); grid = -1; return; }
        grid = cus;
    }
    if (grid < 0) return;
    Args a{};
    for (int i = 0; i < 29; ++i) a.in[i] = (const float*)d_in[i];
    a.out = (float*)d_out; a.ws = (unsigned char*)d_ws;
    void* args[] = {&a};
    hipError_t e = hipLaunchCooperativeKernel((const void*)mega_fwd, dim3(grid), dim3(NWAVES * 64), args, LDS_BYTES, stream);
    if (e != hipSuccess) fprintf(stderr, "cooperative launch failed: %s (grid %d)\n", hipGetErrorString(e), grid);
}
```
